# Optimizing an MI355X kernel written in HIP

```python
import math
import jax, jax.numpy as jnp
from jax import lax
import numpy as np

D_MODEL = 2048
BATCH = 4
SEQ = 4096
DEPTH = 1

MIX_WIDTH = D_MODEL
DIFF_WIDTH = MIX_WIDTH // 2
MLA_WIDTH = MIX_WIDTH - DIFF_WIDTH

DH_DIFF = 64
DV_DIFF = 2 * DH_DIFF
H_DIFF = DIFF_WIDTH // DV_DIFF

QK_NOPE = 128
QK_ROPE = 64
QK_HEAD = QK_NOPE + QK_ROPE
V_MLA = 128
H_MLA = MLA_WIDTH // V_MLA
Q_LORA = 512
KV_LORA = 256
ROPE_THETA = 10000.0

D_FF = ((8 * D_MODEL + 3 * 256 - 1) // (3 * 256)) * 256

REL_BUCKETS = 32
REL_MAX_DIST = 128
Q_BLOCK = 128
EPS = 1e-6

Q_DIFF_COLS = H_DIFF * 2 * DH_DIFF
K_DIFF_COLS = H_DIFF * 2 * DH_DIFF
V_DIFF_COLS = H_DIFF * DV_DIFF
IN_COLS = Q_DIFF_COLS + K_DIFF_COLS + V_DIFF_COLS + Q_LORA + KV_LORA + QK_ROPE

kernel_name = "hybrid_diffattn_mla_adaln_encoder"


def rms_norm(x, g):
    xf = x.astype(jnp.float32)
    y = xf * lax.rsqrt(jnp.mean(xf * xf, axis=-1, keepdims=True) + EPS)
    return (y * g.astype(jnp.float32)).astype(x.dtype)


def t5_bucket(rel):
    nb = REL_BUCKETS // 2
    max_exact = nb // 2
    base = jnp.where(rel > 0, nb, 0)
    n = jnp.abs(rel)
    nf = jnp.maximum(n, 1).astype(jnp.float32)
    large = max_exact + (jnp.log(nf / max_exact) / math.log(REL_MAX_DIST / max_exact)
                         * (nb - max_exact)).astype(jnp.int32)
    large = jnp.minimum(large, nb - 1)
    return base + jnp.where(n < max_exact, n, large)


def rope_tables(seq):
    pos = jnp.arange(seq, dtype=jnp.float32)
    inv = 1.0 / (ROPE_THETA ** (jnp.arange(0, QK_ROPE, 2, dtype=jnp.float32) / QK_ROPE))
    ang = pos[:, None] * inv[None, :]
    return jnp.cos(ang)[:, None, :], jnp.sin(ang)[:, None, :]


def rope_tail(x, cos, sin):
    nope, pe = x[..., :QK_NOPE], x[..., QK_NOPE:]
    half = QK_ROPE // 2
    x1, x2 = pe[..., :half], pe[..., half:]
    c, s = cos.astype(x.dtype), sin.astype(x.dtype)
    return jnp.concatenate([nope, x1 * c - x2 * s, x2 * c + x1 * s], axis=-1)


def to_blocks(t):
    b, s = t.shape[:2]
    return jnp.moveaxis(t.reshape(b, s // Q_BLOCK, Q_BLOCK, *t.shape[2:]), 1, 0)


def from_blocks(t):
    t = jnp.moveaxis(t, 0, 1)
    return t.reshape(t.shape[0], t.shape[1] * t.shape[2], *t.shape[3:])


def differential_attention(q, k, v, lam, rel_bias):
    s = q.shape[1]
    scale = DH_DIFF ** -0.5
    k_pos = jnp.arange(s, dtype=jnp.int32)
    lam32 = lam.astype(jnp.float32)

    def block(args):
        q_blk, i = args
        logits = jnp.einsum('bqhcd,bkhcd->bchqk', q_blk, k).astype(jnp.float32) * scale
        q_pos = i * Q_BLOCK + jnp.arange(Q_BLOCK, dtype=jnp.int32)
        bias = rel_bias[t5_bucket(k_pos[None, :] - q_pos[:, None])]
        logits = logits + jnp.transpose(bias, (2, 0, 1)).astype(jnp.float32)
        p = jax.nn.softmax(logits, axis=-1)
        a = (p[:, 0] - lam32 * p[:, 1]).astype(v.dtype)
        return jnp.einsum('bhqk,bkhe->bqhe', a, v)

    out = lax.map(block, (to_blocks(q), jnp.arange(s // Q_BLOCK, dtype=jnp.int32)))
    return from_blocks(out)


def latent_attention(q, k, v):
    scale = QK_HEAD ** -0.5

    def block(q_blk):
        logits = jnp.einsum('bqhd,bkhd->bhqk', q_blk, k).astype(jnp.float32) * scale
        p = jax.nn.softmax(logits, axis=-1).astype(v.dtype)
        return jnp.einsum('bhqk,bkhd->bqhd', p, v)

    return from_blocks(lax.map(block, to_blocks(q)))


def setup_inputs(seed: int = 0) -> dict:
    key = jax.random.key(seed)
    ks = jax.random.split(key, 24)
    f32 = jnp.float32
    L = DEPTH

    def w(k, shape, fan_in, scale=1.0):
        return jax.random.normal(k, shape, f32) * (scale * fan_in ** -0.5)

    def gain(k, shape):
        return 1.0 + 0.02 * jax.random.normal(k, shape, f32)

    return {
        "x": jax.random.normal(ks[0], (BATCH, SEQ, D_MODEL), f32),
        "c": jax.random.normal(ks[1], (BATCH, D_MODEL), f32),
        "rel_bias": 0.5 * jax.random.normal(ks[2], (REL_BUCKETS, H_DIFF), f32),
        "w_ada": w(ks[3], (L, D_MODEL, 6 * D_MODEL), D_MODEL, 0.5),
        "b_ada": 0.1 * jax.random.normal(ks[4], (L, 6 * D_MODEL), f32),
        "g_norm1": gain(ks[5], (L, D_MODEL)),
        "w_in": w(ks[6], (L, D_MODEL, IN_COLS), D_MODEL),
        "g_q_diff": gain(ks[7], (L, DH_DIFF)),
        "g_k_diff": gain(ks[8], (L, DH_DIFF)),
        "lambda_vecs": 0.1 * jax.random.normal(ks[9], (L, 4, DH_DIFF), f32),
        "g_subln": gain(ks[10], (L, DV_DIFF)),
        "g_q_a": gain(ks[11], (L, Q_LORA)),
        "w_q_b": w(ks[12], (L, Q_LORA, H_MLA * QK_HEAD), Q_LORA),
        "g_kv_a": gain(ks[13], (L, KV_LORA)),
        "w_kv_b": w(ks[14], (L, KV_LORA, H_MLA * (QK_NOPE + V_MLA)), KV_LORA),
        "g_q_mla": gain(ks[15], (L, QK_HEAD)),
        "g_k_mla": gain(ks[16], (L, QK_HEAD)),
        "w_out": w(ks[17], (L, MIX_WIDTH, D_MODEL), MIX_WIDTH),
        "g_norm2": gain(ks[18], (L, D_MODEL)),
        "w_gate": w(ks[19], (L, D_MODEL, D_FF), D_MODEL),
        "w_up": w(ks[20], (L, D_MODEL, D_FF), D_MODEL),
        "w_down": w(ks[21], (L, D_FF, D_MODEL), D_FF),
    }


def reference(x, c, rel_bias, w_ada, b_ada, g_norm1, w_in, g_q_diff, g_k_diff, lambda_vecs,
              g_subln, g_q_a, w_q_b, g_kv_a, w_kv_b, g_q_mla, g_k_mla, w_out,
              g_norm2, w_gate, w_up, w_down):
    b, s, _ = x.shape
    cos, sin = rope_tables(s)
    c_act = jax.nn.silu(c)

    for l in range(DEPTH):
        lambda_init = 0.8 - 0.6 * math.exp(-0.3 * l)
        mod = c_act @ w_ada[l] + b_ada[l]
        sh1, sc1, gt1, sh2, sc2, gt2 = [m[:, None, :] for m in jnp.split(mod, 6, axis=-1)]

        h = rms_norm(x, g_norm1[l]) * (1 + sc1) + sh1
        proj = h @ w_in[l]
        o = 0
        q_d = proj[..., o:o + Q_DIFF_COLS].reshape(b, s, H_DIFF, 2, DH_DIFF); o += Q_DIFF_COLS
        k_d = proj[..., o:o + K_DIFF_COLS].reshape(b, s, H_DIFF, 2, DH_DIFF); o += K_DIFF_COLS
        v_d = proj[..., o:o + V_DIFF_COLS].reshape(b, s, H_DIFF, DV_DIFF); o += V_DIFF_COLS
        cq = proj[..., o:o + Q_LORA]; o += Q_LORA
        ckv = proj[..., o:o + KV_LORA]; o += KV_LORA
        k_pe = proj[..., o:o + QK_ROPE]

        lv = lambda_vecs[l]
        lam = (jnp.exp(jnp.sum(lv[0] * lv[1])) - jnp.exp(jnp.sum(lv[2] * lv[3]))
               + lambda_init)
        q_d = rms_norm(q_d, g_q_diff[l])
        k_d = rms_norm(k_d, g_k_diff[l])
        a_out = differential_attention(q_d, k_d, v_d, lam, rel_bias)
        a_out = (rms_norm(a_out, g_subln[l]) * (1.0 - lambda_init)).reshape(b, s, DIFF_WIDTH)

        q_m = (rms_norm(cq, g_q_a[l]) @ w_q_b[l]).reshape(b, s, H_MLA, QK_HEAD)
        kv = (rms_norm(ckv, g_kv_a[l]) @ w_kv_b[l]).reshape(b, s, H_MLA, QK_NOPE + V_MLA)
        k_nope, v_m = kv[..., :QK_NOPE], kv[..., QK_NOPE:]
        k_m = jnp.concatenate(
            [k_nope, jnp.broadcast_to(k_pe[:, :, None, :], (b, s, H_MLA, QK_ROPE))], axis=-1)
        q_m = rope_tail(rms_norm(q_m, g_q_mla[l]), cos, sin)
        k_m = rope_tail(rms_norm(k_m, g_k_mla[l]), cos, sin)
        b_out = latent_attention(q_m, k_m, v_m).reshape(b, s, MLA_WIDTH)

        mix = jnp.concatenate([a_out, b_out], axis=-1) @ w_out[l]
        x = x + gt1 * mix

        h2 = rms_norm(x, g_norm2[l]) * (1 + sc2) + sh2
        ffn = (jax.nn.silu(h2 @ w_gate[l]) * (h2 @ w_up[l])) @ w_down[l]
        x = x + gt2 * ffn

    return x
```

```cpp
#include <hip/hip_runtime.h>
#include <cstdio>
#include <cstdint>

#ifndef MK_LAUNCHES
#define MK_LAUNCHES 1
#endif

#define LAS __attribute__((address_space(3)))
#define GAS __attribute__((address_space(1)))
typedef unsigned short bf16_t;
typedef short bf16x8 __attribute__((ext_vector_type(8)));
typedef short s16x4 __attribute__((ext_vector_type(4)));
typedef float f32x4 __attribute__((ext_vector_type(4)));
typedef float f32x2 __attribute__((ext_vector_type(2)));
typedef float f32x16 __attribute__((ext_vector_type(16)));
typedef unsigned u32x4 __attribute__((ext_vector_type(4)));
typedef unsigned u32x2 __attribute__((ext_vector_type(2)));

constexpr int BATCH = 4, SEQ = 4096, DM = 2048, M = BATCH * SEQ, DFF = 5632, INC = 3904, INP = 4096, MODW = 6 * DM;
constexpr float EPS = 1e-6f, LOG2E = 1.4426950408889634f;
constexpr float QD_SCALE = 0.125f * LOG2E;
constexpr float QM_SCALE = 0.07216878364870322f * LOG2E;

typedef __bf16 bf16x2n_t __attribute__((ext_vector_type(2)));
typedef float f32x2n_t __attribute__((ext_vector_type(2)));
__device__ __forceinline__ unsigned cvt_pk_bf16_ord(float lo, float hi) { unsigned r; asm volatile("v_cvt_pk_bf16_f32 %0, %1, %2" : "=v"(r) : "v"(lo), "v"(hi)); return r; }
__device__ __forceinline__ unsigned cvt_pk_bf16(float lo, float hi) { const f32x2n_t v = {lo, hi}; const bf16x2n_t b = __builtin_convertvector(v, bf16x2n_t); return __builtin_bit_cast(unsigned, b); }
__device__ __forceinline__ int pk4_fp8(float a, float b, float c, float d) { int r = 0; r = __builtin_amdgcn_cvt_pk_fp8_f32(a, b, r, false); r = __builtin_amdgcn_cvt_pk_fp8_f32(c, d, r, true); return r; }
__device__ __forceinline__ float rsq(float x) { return __builtin_amdgcn_rsqf(x); }
__device__ __forceinline__ float ex2(float x) { return __builtin_amdgcn_exp2f(x); }

namespace pg8 {
constexpr int BM = 256, BK = 64, HALF = 128, HTB = HALF * BK * 2, STAGE_BYTES = 8 * HTB, NXCD = 8, WGM = 8;
__host__ __device__ __forceinline__ int lds_byte(int r, int c) { const int st = (r >> 4) * 2 + (c >> 5), rr = r & 15, cc = c & 31, ob = rr * 64 + cc * 2; return st * 1024 + (ob ^ (((ob >> 9) & 1) << 5)); }
__host__ __device__ __forceinline__ void stage_rc(int b, int& R, int& C) { const int st = b / 1024, sb = b % 1024, swz = sb ^ (((sb >> 9) & 1) << 5); R = (st >> 1) * 16 + swz / 64; C = (st & 1) * 32 + (swz % 64) / 2; }
struct Unit { int pm, pn; };
struct Gemm { const bf16_t* A; const bf16_t* Bt; int M, N, K; };
struct StaticOrder {
    int nM, nN, nwg, G, c;
    __host__ __device__ void init(int M_, int N_, int G_, int c_) { nM = M_ / BM; nN = N_ / BM; nwg = nM * nN; G = G_; c = c_; }
    __host__ __device__ bool next(int i, Unit& u) const {
        const long L = (long)i * G + c; if (L >= nwg) return false;
        int wgid = (int)L; { const int q = nwg / NXCD, r = nwg % NXCD, xcd = wgid % NXCD, off = wgid / NXCD; wgid = (xcd < r ? xcd * (q + 1) : r * (q + 1) + (xcd - r) * q) + off; }
        const int nig = WGM * nN, gid = wgid / nig, fm = gid * WGM, gsz = (nM - fm) < WGM ? (nM - fm) : WGM;
        u.pm = fm + ((wgid % nig) % gsz); u.pn = (wgid % nig) / gsz; return true;
    }
};
typedef f32x4 Acc[2][2][4][2];

template <class Epi>
__device__ __forceinline__ void gemm_phase(LAS unsigned char* lds, const Gemm g, const StaticOrder& S, const Epi& E) {
    int tid = threadIdx.x; asm volatile("" : "+v"(tid));
    const int wid = __builtin_amdgcn_readfirstlane(tid >> 6), lane = tid & 63, wr = wid >> 2, wc = wid & 3, fr = lane & 15, fq = lane >> 4;
    const int K = g.K, nt = K / BK;
    unsigned voffA[2];
#pragma unroll
    for (int i = 0; i < 2; ++i) { int R, C; stage_rc(tid * 16 + i * 8192, R, C); voffA[i] = (unsigned)(R * K + C) * 2u; }
    const size_t kstep = (size_t)(BK * 2);
    const size_t hstep = (size_t)HALF * K * 2;
    const size_t tstep = 2 * hstep;
    const unsigned ldsw = (unsigned)wid * 1024u;
    const int aoff = lds_byte(wr * 64 + fr, fq * 8), boff = lds_byte(wc * 32 + fr, fq * 8);
#define PG8_SA(b, h) (((b) * 2 + (h)) * HTB)
#define PG8_SB(b, h) ((4 + (b) * 2 + (h)) * HTB)
#define PG8_STAGE(bufoff, gbase, voff) do { _Pragma("unroll") for (int _i = 0; _i < 2; ++_i) \
        __builtin_amdgcn_global_load_lds((const unsigned*)((const char*)(gbase) + (voff)[_i]), (LAS unsigned*)(lds + (bufoff) + ldsw + _i * 8192), 16, 0, 0); } while (0)
#define PG8_LDA(dst, b, h) do { _Pragma("unroll") for (int m = 0; m < 4; ++m) _Pragma("unroll") for (int k = 0; k < 2; ++k) dst[m][k] = *(const LAS bf16x8*)(lds + PG8_SA(b, h) + aoff + m * 2048 + k * 1024); } while (0)
#define PG8_LDB(dst, b, h) do { _Pragma("unroll") for (int n = 0; n < 2; ++n) _Pragma("unroll") for (int k = 0; k < 2; ++k) dst[n][k] = *(const LAS bf16x8*)(lds + PG8_SB(b, h) + boff + n * 2048 + k * 1024); } while (0)
#define PG8_MMA(ai, bj, At, Bt) do { __builtin_amdgcn_s_setprio(1); _Pragma("unroll") for (int m = 0; m < 4; ++m) _Pragma("unroll") for (int n = 0; n < 2; ++n) _Pragma("unroll") for (int k = 0; k < 2; ++k) \
        acc[ai][bj][m][n] = __builtin_amdgcn_mfma_f32_16x16x32_bf16(Bt[n][k], At[m][k], acc[ai][bj][m][n], 0, 0, 0); __builtin_amdgcn_s_setprio(0); } while (0)
#define PG8_WAIT_V(n) asm volatile("s_waitcnt vmcnt(" #n ")" ::: "memory")
#define PG8_WAIT_L(n) asm volatile("s_waitcnt lgkmcnt(" #n ")" ::: "memory")
#define PG8_BAR __builtin_amdgcn_s_barrier()
#define PG8_SCHED __builtin_amdgcn_sched_barrier(0)
    Unit cur, nxt; int ui = 0;
    if (!S.next(0, cur)) return;
    Acc acc;
#pragma unroll
    for (int a = 0; a < 2; ++a)
#pragma unroll
        for (int b = 0; b < 2; ++b)
#pragma unroll
            for (int m = 0; m < 4; ++m)
#pragma unroll
                for (int n = 0; n < 2; ++n) acc[a][b][m][n] = (f32x4){0.f, 0.f, 0.f, 0.f};
    bf16x8 At[4][2], B0[2][2], B1[2][2];
    const char* cA = (const char*)g.A + (size_t)cur.pm * tstep; const char* cB = (const char*)g.Bt + (size_t)cur.pn * tstep;
    PG8_STAGE(PG8_SB(0, 0), cB, voffA); PG8_STAGE(PG8_SB(0, 1), cB + hstep, voffA); PG8_STAGE(PG8_SA(0, 0), cA, voffA); PG8_STAGE(PG8_SA(0, 1), cA + hstep, voffA);
    if (wr == 1) PG8_BAR;
    PG8_WAIT_V(2); PG8_BAR;
    PG8_STAGE(PG8_SB(1, 0), cB + kstep, voffA); PG8_STAGE(PG8_SA(1, 0), cA + kstep, voffA); PG8_STAGE(PG8_SB(1, 1), cB + hstep + kstep, voffA);
    PG8_WAIT_V(6); PG8_BAR;
    for (;;) {
        const bool has_next = S.next(ui + 1, nxt);
        const char* nA = has_next ? (const char*)g.A + (size_t)nxt.pm * tstep : cA; const char* nB = has_next ? (const char*)g.Bt + (size_t)nxt.pn * tstep : cB;
        for (int t = 0; t < nt; t += 2) {
            const bool last = (t == nt - 2);
            const char* a1 = cA + (size_t)(t + 1) * kstep;
            const char* a2 = last ? nA : cA + (size_t)(t + 2) * kstep; const char* b2 = last ? nB : cB + (size_t)(t + 2) * kstep;
            const char* a3 = a2 + kstep; const char* b3 = b2 + kstep;
            PG8_LDB(B0, 0, 0); PG8_LDB(B1, 0, 1); PG8_SCHED; PG8_LDA(At, 0, 0); PG8_STAGE(PG8_SA(1, 1), a1 + hstep, voffA);
            PG8_WAIT_V(8); PG8_WAIT_L(0); PG8_BAR; PG8_MMA(0, 0, At, B0); PG8_MMA(0, 1, At, B1); PG8_BAR; PG8_SCHED;
            PG8_LDA(At, 0, 1); PG8_STAGE(PG8_SB(0, 0), b2, voffA); PG8_STAGE(PG8_SB(0, 1), b2 + hstep, voffA); PG8_STAGE(PG8_SA(0, 0), a2, voffA);
            PG8_WAIT_V(8); PG8_WAIT_L(0); PG8_BAR; PG8_MMA(1, 0, At, B0); PG8_MMA(1, 1, At, B1); PG8_BAR; PG8_SCHED;
            PG8_LDB(B0, 1, 0); PG8_LDB(B1, 1, 1); PG8_SCHED; PG8_LDA(At, 1, 0); PG8_STAGE(PG8_SA(0, 1), a2 + hstep, voffA);
            PG8_WAIT_V(8); PG8_WAIT_L(0); PG8_BAR; PG8_MMA(0, 0, At, B0); PG8_MMA(0, 1, At, B1); PG8_BAR; PG8_SCHED;
            PG8_LDA(At, 1, 1); PG8_STAGE(PG8_SB(1, 0), b3, voffA); PG8_STAGE(PG8_SB(1, 1), b3 + hstep, voffA); PG8_STAGE(PG8_SA(1, 0), a3, voffA);
            PG8_WAIT_V(8); PG8_WAIT_L(0); PG8_BAR; PG8_MMA(1, 0, At, B0); PG8_MMA(1, 1, At, B1); PG8_BAR; PG8_SCHED;
        }
        if (wr == 0) PG8_BAR;
        { int t2_ = threadIdx.x; asm volatile("" : "+v"(t2_));
          E(acc, cur, wr, wc, t2_ & 15, (t2_ & 63) >> 4); }
        if (!has_next) break;
#pragma unroll
        for (int a = 0; a < 2; ++a)
#pragma unroll
            for (int b = 0; b < 2; ++b)
#pragma unroll
                for (int m = 0; m < 4; ++m)
#pragma unroll
                    for (int n = 0; n < 2; ++n) acc[a][b][m][n] = (f32x4){0.f, 0.f, 0.f, 0.f};
        cur = nxt; cA = nA; cB = nB; ++ui;
        if (wr == 1) PG8_BAR;
    }
    PG8_WAIT_V(0);
    PG8_BAR;
#undef PG8_SA
#undef PG8_SB
#undef PG8_STAGE
#undef PG8_LDA
#undef PG8_LDB
#undef PG8_MMA
#undef PG8_WAIT_V
#undef PG8_WAIT_L
#undef PG8_BAR
#undef PG8_SCHED
}
}

__host__ __device__ __forceinline__ int pmap256(int c) { return 128 * ((c >> 5) & 1) + 32 * (c >> 6) + 16 * ((c >> 2) & 1) + 4 * ((c >> 3) & 3) + (c & 3); }
__host__ __device__ __forceinline__ int pmap128(int c) { return 32 * (c >> 5) + 16 * ((c >> 2) & 1) + 4 * ((c >> 3) & 3) + (c & 3); }

#define EPI_BAR() do { asm volatile("s_waitcnt lgkmcnt(0)" ::: "memory"); __builtin_amdgcn_s_barrier(); asm volatile("" ::: "memory"); } while (0)

struct EpiProj {
    bf16_t *QD, *KD, *VD, *CQ, *CKV; float *SSQ_Q, *SSQ_KV, *SSQ_PE, *KR; const float *gq, *gk, *gkm, *ropeC, *ropeS;
    __device__ __forceinline__ void operator()(pg8::Acc& acc, const pg8::Unit& u, int wr, int wc, int fr, int fq) const {
        const int g = u.pn * 4 + wc, rowb = u.pm * 256 + wr * 64 + fr, cl = 8 * fq;
        if (g < 32) {
            const float* gv = g < 16 ? gq : gk; const float sc = g < 16 ? QD_SCALE : 1.f;
            f32x4 gg[2][2];
#pragma unroll
            for (int bj = 0; bj < 2; ++bj)
#pragma unroll
                for (int n = 0; n < 2; ++n) gg[bj][n] = *(const f32x4*)(gv + 32 * bj + cl + 4 * n) * sc;
            bf16_t* dst = QD + (g & 15) * 64 + cl; unsigned char* dst8 = (unsigned char*)KD + (g & 15) * 64 + cl;
#pragma unroll
            for (int ai = 0; ai < 2; ++ai)
#pragma unroll
                for (int m = 0; m < 4; ++m) {
                    const size_t row = (size_t)(rowb + 128 * ai + 16 * m);
                    float ss = 0.f;
#pragma unroll
                    for (int bj = 0; bj < 2; ++bj)
#pragma unroll
                        for (int n = 0; n < 2; ++n) { const f32x4 x = acc[ai][bj][m][n]; ss += (x[0] * x[0] + x[1] * x[1]) + (x[2] * x[2] + x[3] * x[3]); }
                    ss += __shfl_xor(ss, 16); ss += __shfl_xor(ss, 32);
                    const float rs = rsq(ss * (1.f / 64.f) + EPS);
#pragma unroll
                    for (int bj = 0; bj < 2; ++bj) { const f32x4 v0 = acc[ai][bj][m][0] * rs * gg[bj][0], v1 = acc[ai][bj][m][1] * rs * gg[bj][1];
                        if (g < 16) { u32x4 w; w.x = cvt_pk_bf16(v0[0], v0[1]); w.y = cvt_pk_bf16(v0[2], v0[3]); w.z = cvt_pk_bf16(v1[0], v1[1]); w.w = cvt_pk_bf16(v1[2], v1[3]);
                            *(u32x4*)(dst + row * 1024 + 32 * bj) = w; }
                        else { u32x2 w8; w8.x = (unsigned)pk4_fp8(v0[0], v0[1], v0[2], v0[3]); w8.y = (unsigned)pk4_fp8(v1[0], v1[1], v1[2], v1[3]); *(u32x2*)(dst8 + row * 1024 + 32 * bj) = w8; } }
                }
        } else if (g < 60) {
            bf16_t* dst; int ld; float* ssp = nullptr; int sw = 0, si = 0;
            const bool v8 = g < 48;
            if (g < 48) { dst = VD; ld = 0; }
            else if (g < 56) { dst = CQ + (g - 48) * 64 + cl; ld = 512; ssp = SSQ_Q; sw = 8; si = g - 48; }
            else { dst = CKV + (g - 56) * 64 + cl; ld = 256; ssp = SSQ_KV; sw = 4; si = g - 56; }
#pragma unroll
            for (int ai = 0; ai < 2; ++ai)
#pragma unroll
                for (int m = 0; m < 4; ++m) {
                    const size_t row = (size_t)(rowb + 128 * ai + 16 * m);
                    float ss = 0.f;
#pragma unroll
                    for (int bj = 0; bj < 2; ++bj) { const f32x4 v0 = acc[ai][bj][m][0], v1 = acc[ai][bj][m][1];
                        ss += (v0[0] * v0[0] + v0[1] * v0[1]) + (v0[2] * v0[2] + v0[3] * v0[3]) + (v1[0] * v1[0] + v1[1] * v1[1]) + (v1[2] * v1[2] + v1[3] * v1[3]);
                        if (v8) { u32x2 w8; w8.x = (unsigned)pk4_fp8(v0[0], v0[1], v0[2], v0[3]); w8.y = (unsigned)pk4_fp8(v1[0], v1[1], v1[2], v1[3]);
                            const int tok_ = (int)row & (SEQ - 1), k5_ = tok_ & 31, p_ = 32 * ((k5_ >> 2) & 1) + 16 * ((tok_ >> 5) & 1) + (k5_ & 3) + 4 * (k5_ >> 3);
                            unsigned char* dp_ = (unsigned char*)VD + ((size_t)(((int)row >> 12) * 8 + ((g - 32) >> 1)) * 128 + ((g - 32) & 1) * 64 + cl + 32 * bj) * SEQ + (tok_ & ~63) + p_;
                            dp_[0] = (unsigned char)(w8.x); dp_[SEQ] = (unsigned char)(w8.x >> 8); dp_[2 * SEQ] = (unsigned char)(w8.x >> 16); dp_[3 * SEQ] = (unsigned char)(w8.x >> 24);
                            dp_[4 * SEQ] = (unsigned char)(w8.y); dp_[5 * SEQ] = (unsigned char)(w8.y >> 8); dp_[6 * SEQ] = (unsigned char)(w8.y >> 16); dp_[7 * SEQ] = (unsigned char)(w8.y >> 24); }
                        else { u32x4 w; w.x = cvt_pk_bf16(v0[0], v0[1]); w.y = cvt_pk_bf16(v0[2], v0[3]); w.z = cvt_pk_bf16(v1[0], v1[1]); w.w = cvt_pk_bf16(v1[2], v1[3]);
                            *(u32x4*)(dst + row * ld + 32 * bj) = w; } }
                    if (ssp) { ss += __shfl_xor(ss, 16); ss += __shfl_xor(ss, 32); if (fq == 0) ssp[row * sw + si] = ss; }
                }
        } else if (g == 60) {
            f32x4 g1[2], g2[2];
#pragma unroll
            for (int n = 0; n < 2; ++n) { g1[n] = *(const f32x4*)(gkm + 128 + cl + 4 * n); g2[n] = *(const f32x4*)(gkm + 160 + cl + 4 * n); }
#pragma unroll
            for (int ai = 0; ai < 2; ++ai)
#pragma unroll
                for (int m = 0; m < 4; ++m) {
                    const size_t row = (size_t)(rowb + 128 * ai + 16 * m); const int pos = (int)(row & (SEQ - 1));
                    float ss = 0.f;
#pragma unroll
                    for (int n = 0; n < 2; ++n) { const f32x4 x1 = acc[ai][0][m][n], x2 = acc[ai][1][m][n];
                        ss += (x1[0] * x1[0] + x1[1] * x1[1]) + (x1[2] * x1[2] + x1[3] * x1[3]) + (x2[0] * x2[0] + x2[1] * x2[1]) + (x2[2] * x2[2] + x2[3] * x2[3]);
                        const f32x4 c = *(const f32x4*)(ropeC + pos * 32 + cl + 4 * n), s = *(const f32x4*)(ropeS + pos * 32 + cl + 4 * n);
                        const f32x4 a = x1 * g1[n], b = x2 * g2[n];
                        *(f32x4*)(KR + row * 64 + cl + 4 * n) = a * c - b * s;
                        *(f32x4*)(KR + row * 64 + 32 + cl + 4 * n) = b * c + a * s; }
                    ss += __shfl_xor(ss, 16); ss += __shfl_xor(ss, 32); if (fq == 0) SSQ_PE[row] = ss;
                }
        }
    }
};

struct EpiQ {
    bf16_t* QM; const float *SSQ_Q, *gqm, *ropeC, *ropeS; LAS float* P;
    __device__ __forceinline__ void operator()(pg8::Acc& acc, const pg8::Unit& u, int wr, int wc, int fr, int fq) const {
        const int h = u.pn, rowb = u.pm * 256 + wr * 64 + fr, cl = 8 * fq;
#pragma unroll
        for (int ai = 0; ai < 2; ++ai)
#pragma unroll
            for (int m = 0; m < 4; ++m) {
                const size_t row = (size_t)(rowb + 128 * ai + 16 * m);
                const f32x4 s0 = *(const f32x4*)(SSQ_Q + row * 8), s1 = *(const f32x4*)(SSQ_Q + row * 8 + 4);
                const float ra = rsq(((s0[0] + s0[1]) + (s0[2] + s0[3]) + (s1[0] + s1[1]) + (s1[2] + s1[3])) * (1.f / 512.f) + EPS);
                float ss = 0.f;
#pragma unroll
                for (int bj = 0; bj < 2; ++bj)
#pragma unroll
                    for (int n = 0; n < 2; ++n) { const f32x4 x = acc[ai][bj][m][n] * ra; acc[ai][bj][m][n] = x; ss += (x[0] * x[0] + x[1] * x[1]) + (x[2] * x[2] + x[3] * x[3]); }
                ss += __shfl_xor(ss, 16); ss += __shfl_xor(ss, 32);
                if (fq == 0) P[(128 * ai + 64 * wr + 16 * m + fr) * 4 + wc] = ss;
            }
        EPI_BAR();
        if (wc < 3) {
            f32x4 gg[2][2];
#pragma unroll
            for (int bj = 0; bj < 2; ++bj)
#pragma unroll
                for (int n = 0; n < 2; ++n) gg[bj][n] = *(const f32x4*)(gqm + 64 * wc + 32 * bj + cl + 4 * n) * QM_SCALE;
#pragma unroll
            for (int ai = 0; ai < 2; ++ai)
#pragma unroll
                for (int m = 0; m < 4; ++m) {
                    const size_t row = (size_t)(rowb + 128 * ai + 16 * m);
                    const f32x4 pp = *(const LAS f32x4*)(P + (128 * ai + 64 * wr + 16 * m + fr) * 4);
                    const float rs = rsq((pp[0] + pp[1] + pp[2]) * (1.f / 192.f) + EPS);
                    bf16_t* dst = QM + row * 1536 + h * 192 + 64 * wc + cl;
                    f32x4 v[2][2];
#pragma unroll
                    for (int bj = 0; bj < 2; ++bj)
#pragma unroll
                        for (int n = 0; n < 2; ++n) v[bj][n] = acc[ai][bj][m][n] * rs * gg[bj][n];
#pragma unroll
                    for (int bj = 0; bj < 2; ++bj) { u32x4 w; w.x = cvt_pk_bf16_ord(v[bj][0][0], v[bj][0][1]); w.y = cvt_pk_bf16_ord(v[bj][0][2], v[bj][0][3]); w.z = cvt_pk_bf16_ord(v[bj][1][0], v[bj][1][1]); w.w = cvt_pk_bf16_ord(v[bj][1][2], v[bj][1][3]);
                        *(u32x4*)(dst + 32 * bj) = w; }
                }
        }
    }
};

struct EpiKV {
    unsigned char *K8, *V8; const float *SSQ_KV, *SSQ_PE, *KR, *gkm; LAS float* P;
    __device__ __forceinline__ void operator()(pg8::Acc& acc, const pg8::Unit& u, int wr, int wc, int fr, int fq) const {
        const int h = u.pn, rowb = u.pm * 256 + wr * 64 + fr, cl = 8 * fq;
#pragma unroll
        for (int ai = 0; ai < 2; ++ai)
#pragma unroll
            for (int m = 0; m < 4; ++m) {
                const size_t row = (size_t)(rowb + 128 * ai + 16 * m);
                const f32x4 s0 = *(const f32x4*)(SSQ_KV + row * 4);
                const float ra = rsq(((s0[0] + s0[1]) + (s0[2] + s0[3])) * (1.f / 256.f) + EPS);
                float ss = 0.f;
#pragma unroll
                for (int bj = 0; bj < 2; ++bj)
#pragma unroll
                    for (int n = 0; n < 2; ++n) { const f32x4 x = acc[ai][bj][m][n] * ra; acc[ai][bj][m][n] = x; ss += (x[0] * x[0] + x[1] * x[1]) + (x[2] * x[2] + x[3] * x[3]); }
                if (wc < 2) { ss += __shfl_xor(ss, 16); ss += __shfl_xor(ss, 32); if (fq == 0) P[(128 * ai + 64 * wr + 16 * m + fr) * 4 + wc] = ss; }
                else {
                    const int tok_ = (int)row & (SEQ - 1), k5_ = tok_ & 31, p_ = 32 * ((k5_ >> 2) & 1) + 16 * ((tok_ >> 5) & 1) + (k5_ & 3) + 4 * (k5_ >> 3);
                    unsigned char* dp_ = V8 + ((size_t)(((int)row >> 12) * 8 + h) * 128 + 64 * (wc - 2) + cl) * SEQ + (tok_ & ~63) + p_;
#pragma unroll
                    for (int bj = 0; bj < 2; ++bj) { const f32x4 v0 = acc[ai][bj][m][0], v1 = acc[ai][bj][m][1];
                        const unsigned w0 = (unsigned)pk4_fp8(v0[0], v0[1], v0[2], v0[3]), w1 = (unsigned)pk4_fp8(v1[0], v1[1], v1[2], v1[3]); unsigned char* q_ = dp_ + (size_t)(32 * bj) * SEQ;
                        q_[0] = (unsigned char)w0; q_[SEQ] = (unsigned char)(w0 >> 8); q_[2 * SEQ] = (unsigned char)(w0 >> 16); q_[3 * SEQ] = (unsigned char)(w0 >> 24);
                        q_[4 * SEQ] = (unsigned char)w1; q_[5 * SEQ] = (unsigned char)(w1 >> 8); q_[6 * SEQ] = (unsigned char)(w1 >> 16); q_[7 * SEQ] = (unsigned char)(w1 >> 24); } }
            }
        EPI_BAR();
        if (wc < 2) {
            f32x4 gg[2][2];
#pragma unroll
            for (int bj = 0; bj < 2; ++bj)
#pragma unroll
                for (int n = 0; n < 2; ++n) gg[bj][n] = *(const f32x4*)(gkm + 64 * wc + 32 * bj + cl + 4 * n);
#pragma unroll
            for (int ai = 0; ai < 2; ++ai)
#pragma unroll
                for (int m = 0; m < 4; ++m) {
                    const size_t row = (size_t)(rowb + 128 * ai + 16 * m);
                    const f32x2 pp = *(const LAS f32x2*)(P + (128 * ai + 64 * wr + 16 * m + fr) * 4);
                    const float rs = rsq((pp[0] + pp[1] + SSQ_PE[row]) * (1.f / 192.f) + EPS);
                    unsigned char* dst = K8 + row * 1536 + h * 192 + 64 * wc + cl;
#pragma unroll
                    for (int bj = 0; bj < 2; ++bj) { const f32x4 v0 = acc[ai][bj][m][0] * rs * gg[bj][0], v1 = acc[ai][bj][m][1] * rs * gg[bj][1];
                        u32x2 w; w.x = (unsigned)pk4_fp8(v0[0], v0[1], v0[2], v0[3]); w.y = (unsigned)pk4_fp8(v1[0], v1[1], v1[2], v1[3]);
                        *(u32x2*)(dst + 32 * bj) = w; }
                }
        } else {
            const int co = 32 * (wc - 2) + cl;
            f32x4 ka[2][4], kb2[2][4];
#pragma unroll
            for (int ai = 0; ai < 2; ++ai)
#pragma unroll
                for (int m = 0; m < 4; ++m) { const size_t row = (size_t)(rowb + 128 * ai + 16 * m); ka[ai][m] = *(const f32x4*)(KR + row * 64 + co); kb2[ai][m] = *(const f32x4*)(KR + row * 64 + co + 4); }
#pragma unroll
            for (int ai = 0; ai < 2; ++ai)
#pragma unroll
                for (int m = 0; m < 4; ++m) {
                    const size_t row = (size_t)(rowb + 128 * ai + 16 * m);
                    const f32x2 pp = *(const LAS f32x2*)(P + (128 * ai + 64 * wr + 16 * m + fr) * 4);
                    const float rs = rsq((pp[0] + pp[1] + SSQ_PE[row]) * (1.f / 192.f) + EPS);
                    const f32x4 a = ka[ai][m] * rs, b = kb2[ai][m] * rs;
                    u32x2 w; w.x = (unsigned)pk4_fp8(a[0], a[1], a[2], a[3]); w.y = (unsigned)pk4_fp8(b[0], b[1], b[2], b[3]);
                    *(u32x2*)(K8 + row * 1536 + h * 192 + 128 + co) = w; }
        }
    }
};

__device__ __forceinline__ float bf2f(unsigned short v) { return __uint_as_float((unsigned)v << 16); }
struct EpiRes1 {
    const float* base; const float* gate; bf16_t* out;
    __device__ __forceinline__ void operator()(pg8::Acc& acc, const pg8::Unit& u, int wr, int wc, int fr, int fq) const {
        const int rowb = u.pm * 256 + wr * 64 + fr, col0 = u.pn * 256 + wc * 32 + 8 * fq; const int b = u.pm >> 4;
        f32x4 gt[2][2];
#pragma unroll
        for (int bj = 0; bj < 2; ++bj)
#pragma unroll
            for (int n = 0; n < 2; ++n) gt[bj][n] = *(const f32x4*)(gate + (size_t)b * MODW + col0 + 128 * bj + 4 * n);
#pragma unroll
        for (int ai = 0; ai < 2; ++ai) {
            f32x4 bs[4][2][2];
#pragma unroll
            for (int m = 0; m < 4; ++m) { const size_t off = (size_t)(rowb + 128 * ai + 16 * m) * DM + col0;
#pragma unroll
                for (int bj = 0; bj < 2; ++bj)
#pragma unroll
                    for (int n = 0; n < 2; ++n) bs[m][bj][n] = __builtin_nontemporal_load((const f32x4*)(base + off + 128 * bj + 4 * n)); }
#pragma unroll
            for (int m = 0; m < 4; ++m) { const size_t off = (size_t)(rowb + 128 * ai + 16 * m) * DM + col0;
#pragma unroll
                for (int bj = 0; bj < 2; ++bj) { const f32x4 v0 = bs[m][bj][0] + gt[bj][0] * acc[ai][bj][m][0], v1 = bs[m][bj][1] + gt[bj][1] * acc[ai][bj][m][1];
                    u32x4 w; w.x = cvt_pk_bf16(v0[0], v0[1]); w.y = cvt_pk_bf16(v0[2], v0[3]); w.z = cvt_pk_bf16(v1[0], v1[1]); w.w = cvt_pk_bf16(v1[2], v1[3]);
                    *(u32x4*)(out + off + 128 * bj) = w; } }
        }
    }
};
struct EpiRes2 {
    const bf16_t* base; const float* gate; float* out;
    __device__ __forceinline__ void operator()(pg8::Acc& acc, const pg8::Unit& u, int wr, int wc, int fr, int fq) const {
        const int rowb = u.pm * 256 + wr * 64 + fr, col0 = u.pn * 256 + wc * 32 + 8 * fq; const int b = u.pm >> 4;
        f32x4 gt[2][2];
#pragma unroll
        for (int bj = 0; bj < 2; ++bj)
#pragma unroll
            for (int n = 0; n < 2; ++n) gt[bj][n] = *(const f32x4*)(gate + (size_t)b * MODW + col0 + 128 * bj + 4 * n);
#pragma unroll
        for (int ai = 0; ai < 2; ++ai) {
            bf16x8 bs[4][2];
#pragma unroll
            for (int m = 0; m < 4; ++m) { const size_t off = (size_t)(rowb + 128 * ai + 16 * m) * DM + col0;
#pragma unroll
                for (int bj = 0; bj < 2; ++bj) bs[m][bj] = *(const bf16x8*)(base + off + 128 * bj); }
#pragma unroll
            for (int m = 0; m < 4; ++m) { const size_t off = (size_t)(rowb + 128 * ai + 16 * m) * DM + col0;
#pragma unroll
                for (int bj = 0; bj < 2; ++bj) { const bf16x8 r = bs[m][bj];
                    const f32x4 x0 = {bf2f((unsigned short)r[0]), bf2f((unsigned short)r[1]), bf2f((unsigned short)r[2]), bf2f((unsigned short)r[3])};
                    const f32x4 x1 = {bf2f((unsigned short)r[4]), bf2f((unsigned short)r[5]), bf2f((unsigned short)r[6]), bf2f((unsigned short)r[7])};
                    *(f32x4*)(out + off + 128 * bj) = x0 + gt[bj][0] * acc[ai][bj][m][0];
                    *(f32x4*)(out + off + 128 * bj + 4) = x1 + gt[bj][1] * acc[ai][bj][m][1]; } }
        }
    }
};

struct EpiSwiglu {
    bf16_t* H;
    __device__ __forceinline__ void operator()(pg8::Acc& acc, const pg8::Unit& u, int wr, int wc, int fr, int fq) const {
        const int rowb = u.pm * 256 + wr * 64 + fr, col0 = u.pn * 128 + wc * 32 + 8 * fq;
#pragma unroll
        for (int ai = 0; ai < 2; ++ai)
#pragma unroll
            for (int m = 0; m < 4; ++m) { bf16_t* dst = H + (size_t)(rowb + 128 * ai + 16 * m) * DFF + col0;
                f32x4 hv[2];
#pragma unroll
                for (int n = 0; n < 2; ++n) { const f32x4 gv = acc[ai][0][m][n], uv = acc[ai][1][m][n];
#pragma unroll
                    for (int j = 0; j < 4; ++j) hv[n][j] = gv[j] * __builtin_amdgcn_rcpf(1.f + ex2(-gv[j] * LOG2E)) * uv[j]; }
                u32x4 w; w.x = cvt_pk_bf16(hv[0][0], hv[0][1]); w.y = cvt_pk_bf16(hv[0][2], hv[0][3]); w.z = cvt_pk_bf16(hv[1][0], hv[1][1]); w.w = cvt_pk_bf16(hv[1][2], hv[1][3]);
                *(u32x4*)dst = w; }
    }
};

namespace att {
#define SBAR() __builtin_amdgcn_sched_barrier(0)
template <int OFF> __device__ __forceinline__ s16x4 tr_read(int vb) { s16x4 r; asm volatile("ds_read_b64_tr_b16 %0, %1 offset:%2" : "=&v"(r) : "v"(vb), "i"(OFF) : "memory"); return r; }
struct Tensors { const bf16_t *Q, *K, *V; bf16_t* MIX; const float *ropeC, *ropeS; };
constexpr int OFF_V = 0, OFF_K = 32768, OFF_WS = 81920, OFF_TBL = 83968, OFF_STG = 86016, OFF_QR = 86016, OFF_XCH = 0;
typedef int i32x8 __attribute__((ext_vector_type(8)));
typedef int i32x4 __attribute__((ext_vector_type(4)));
struct Tensors8 { const bf16_t* Q; const unsigned char* K8; const unsigned char* VT8; bf16_t* MIX; const float *ropeC, *ropeS; };
__device__ __forceinline__ int crow32(int r, int hi) { return (r & 3) + 8 * (r >> 2) + 4 * hi; }
__device__ __forceinline__ f32x16 mfma8(i32x8 a, i32x8 b, f32x16 c) { return __builtin_amdgcn_mfma_scale_f32_32x32x64_f8f6f4(a, b, c, 0, 0, 0, 0, 0, 0); }
typedef short s16x2 __attribute__((ext_vector_type(2)));
__device__ __forceinline__ int pk4_fp8s(int prev, float a, float b, float c, float d) { s16x2 r = __builtin_bit_cast(s16x2, prev);     r = __builtin_amdgcn_cvt_scalef32_pk_fp8_f32(r, a, b, 64.0f, false); r = __builtin_amdgcn_cvt_scalef32_pk_fp8_f32(r, c, d, 64.0f, true); return __builtin_bit_cast(int, r); }
constexpr int M8_OFF_V = 0, M8_VT = 8192, M8_OFF_K = 16384, M8_KT = 12288, M8_OFF_WS = 81920;

__device__ __forceinline__ void attn_unit_mla8(const Tensors8& T, int b, int h, int qblk, LAS char* lds) {
    constexpr int NT = SEQ / 64;
    int tid = threadIdx.x; asm volatile("" : "+v"(tid));
    const int wid = __builtin_amdgcn_readfirstlane(tid >> 6), lane = tid & 63, r32 = lane & 31, hi = lane >> 5;
    const size_t tok0 = (size_t)b * SEQ; const int qw0 = qblk * 256 + wid * 32;
    LAS char* V_lds = lds + M8_OFF_V; LAS char* K_lds = lds + M8_OFF_K;
    i32x8 q8[3];
    { const bf16_t* Qw = T.Q + (tok0 + qw0 + r32) * 1536 + h * 192;
      float v[32];
#pragma unroll
      for (int s = 0; s < 2; ++s) {
#pragma unroll
          for (int c = 0; c < 4; ++c) { const bf16x8 t = *(const bf16x8*)(Qw + 64 * s + 32 * hi + 8 * c);
#pragma unroll
              for (int e = 0; e < 8; ++e) v[8 * c + e] = bf2f((unsigned short)t[e]); }
#pragma unroll
          for (int w = 0; w < 8; ++w) q8[s][w] = pk4_fp8(v[4 * w], v[4 * w + 1], v[4 * w + 2], v[4 * w + 3]); }
      const int pos = qw0 + r32; const float* cp = T.ropeC + pos * 32; const float* sp = T.ropeS + pos * 32;
#pragma unroll
      for (int c = 0; c < 4; ++c) { const bf16x8 t1 = *(const bf16x8*)(Qw + 128 + 8 * c), t2 = *(const bf16x8*)(Qw + 160 + 8 * c);
          const f32x4 c0 = *(const f32x4*)(cp + 8 * c), c1 = *(const f32x4*)(cp + 8 * c + 4), s0 = *(const f32x4*)(sp + 8 * c), s1 = *(const f32x4*)(sp + 8 * c + 4);
#pragma unroll
          for (int e = 0; e < 8; ++e) { const float x1 = bf2f((unsigned short)t1[e]), x2 = bf2f((unsigned short)t2[e]), cc = e < 4 ? c0[e & 3] : c1[e & 3], ss = e < 4 ? s0[e & 3] : s1[e & 3];
              v[8 * c + e] = hi ? (x2 * cc + x1 * ss) : (x1 * cc - x2 * ss); } }
#pragma unroll
      for (int w = 0; w < 8; ++w) q8[2][w] = pk4_fp8(v[4 * w], v[4 * w + 1], v[4 * w + 2], v[4 * w + 3]);
    }
    const unsigned char* Kp = T.K8 + tok0 * 1536 + h * 192; const unsigned char* Vp = T.VT8 + ((size_t)(b * 8 + h) * 128) * SEQ;
    int ksoff[2]; int vsoff;
#pragma unroll
    for (int i = 0; i < 2; ++i) { const int L = 1024 * (wid + 8 * i) + 16 * lane; const int row = L / 192, pc = (L - 192 * row) >> 4, c = (pc & ~3) | ((pc & 3) ^ ((row >> 2) & 3)); ksoff[i] = row * 1536 + 16 * c; }
    { const int d = 16 * wid + (lane >> 2), c = (lane & 3) ^ ((d >> 2) & 3); vsoff = d * SEQ + 16 * c; }
    const int sw = (r32 >> 2) & 3;
    LAS char* kxa[2]; LAS char* vxa[2];
#pragma unroll
    for (int e = 0; e < 2; ++e) { kxa[e] = K_lds + r32 * 192 + 16 * ((2 * hi + e) ^ sw); vxa[e] = V_lds + r32 * 64 + 16 * ((2 * hi + e) ^ sw); }
#define DMA_K(bf) do { __builtin_amdgcn_global_load_lds((const unsigned*)(Kp + ksoff[0]), (LAS unsigned*)(K_lds + (bf) * M8_KT + wid * 1024), 16, 0, 0); \
        if (wid < 4) __builtin_amdgcn_global_load_lds((const unsigned*)(Kp + ksoff[1]), (LAS unsigned*)(K_lds + (bf) * M8_KT + (wid + 8) * 1024), 16, 0, 0); Kp += 64 * 1536; } while (0)
#define DMA_V(bf) do { __builtin_amdgcn_global_load_lds((const unsigned*)(Vp + vsoff), (LAS unsigned*)(V_lds + (bf) * M8_VT + wid * 1024), 16, 0, 0); Vp += 64; } while (0)
#define DMA_K0(bf) do { __builtin_amdgcn_global_load_lds((const unsigned*)(Kp + ksoff[0]), (LAS unsigned*)(K_lds + (bf) * M8_KT + wid * 1024), 16, 0, 0); } while (0)
#define DMA_K1(bf) do { if (wid < 4) __builtin_amdgcn_global_load_lds((const unsigned*)(Kp + ksoff[1]), (LAS unsigned*)(K_lds + (bf) * M8_KT + (wid + 8) * 1024), 16, 0, 0); Kp += 64 * 1536; } while (0)
#define TSYNC() do { asm volatile("s_waitcnt vmcnt(0)" ::: "memory"); __syncthreads(); } while (0)
#define KFR(bf, kb, s) ({ i32x8 f_; const i32x4 lo_ = *(const LAS i32x4*)(kxa[0] + (bf) * M8_KT + (kb) * 32 * 192 + (s) * 64), hi_ = *(const LAS i32x4*)(kxa[1] + (bf) * M8_KT + (kb) * 32 * 192 + (s) * 64); \
        f_[0] = lo_[0]; f_[1] = lo_[1]; f_[2] = lo_[2]; f_[3] = lo_[3]; f_[4] = hi_[0]; f_[5] = hi_[1]; f_[6] = hi_[2]; f_[7] = hi_[3]; f_; })
#define VFR(bf, db) ({ i32x8 f_; const i32x4 lo_ = *(const LAS i32x4*)(vxa[0] + (bf) * M8_VT + (db) * 32 * 64), hi_ = *(const LAS i32x4*)(vxa[1] + (bf) * M8_VT + (db) * 32 * 64); \
        f_[0] = lo_[0]; f_[1] = lo_[1]; f_[2] = lo_[2]; f_[3] = lo_[3]; f_[4] = hi_[0]; f_[5] = hi_[1]; f_[6] = hi_[2]; f_[7] = hi_[3]; f_; })
#define QKT(P, bf) do { _Pragma("unroll") for (int s_ = 0; s_ < 3; ++s_) _Pragma("unroll") for (int kb_ = 0; kb_ < 2; ++kb_) { const i32x8 kf_ = KFR(bf, kb_, s_); P[kb_] = mfma8(kf_, q8[s_], s_ == 0 ? (f32x16){} : P[kb_]); } SBAR(); } while (0)
#define PARTIAL(P) do { _Pragma("unroll") for (int r_ = 0; r_ < 16; ++r_) P[0][r_] = ex2(P[0][r_]); } while (0)
    f32x16 o[4] = {}, lacc = {}; f32x16 pA[2], pB[2]; i32x8 p8 = {};
    const i32x8 ones8 = {0x38383838, 0x38383838, 0x38383838, 0x38383838, 0x38383838, 0x38383838, 0x38383838, 0x38383838};
#define FIND(P, bfK, bfV, DOK) do { \
        _Pragma("unroll") for (int r_ = 0; r_ < 8; ++r_) P[1][r_] = ex2(P[1][r_]); SBAR(); if (DOK) DMA_K(bfK); SBAR(); \
        _Pragma("unroll") for (int r_ = 8; r_ < 16; ++r_) P[1][r_] = ex2(P[1][r_]); SBAR(); DMA_V(bfV); SBAR(); \
        _Pragma("unroll") for (int w_ = 0; w_ < 8; ++w_) p8[w_] = pk4_fp8s(p8[w_], P[w_ >> 2][4 * (w_ & 3)], P[w_ >> 2][4 * (w_ & 3) + 1], P[w_ >> 2][4 * (w_ & 3) + 2], P[w_ >> 2][4 * (w_ & 3) + 3]); \
        lacc = mfma8(p8, ones8, lacc); SBAR(); } while (0)
#define FIN0(P) do { _Pragma("unroll") for (int r_ = 0; r_ < 16; ++r_) P[1][r_] = ex2(P[1][r_]); \
        _Pragma("unroll") for (int w_ = 0; w_ < 8; ++w_) p8[w_] = pk4_fp8s(p8[w_], P[w_ >> 2][4 * (w_ & 3)], P[w_ >> 2][4 * (w_ & 3) + 1], P[w_ >> 2][4 * (w_ & 3) + 2], P[w_ >> 2][4 * (w_ & 3) + 3]); \
        lacc = mfma8(p8, ones8, lacc); SBAR(); } while (0)
#define PV(bf) do { _Pragma("unroll") for (int db_ = 0; db_ < 4; ++db_) { const i32x8 vf_ = VFR(bf, db_); o[db_] = mfma8(p8, vf_, o[db_]); } } while (0)
#define PIN_O() do { _Pragma("unroll") for (int d_ = 0; d_ < 4; ++d_) asm volatile("" : "+v"(o[d_])); } while (0)
    DMA_K(0); TSYNC();
    DMA_K(1); DMA_V(0); QKT(pA, 0); PARTIAL(pA); TSYNC();
#define PIN1(x) asm volatile("" : "+v"(x))
#define MF(Pn, kb_, s_, bf) do { const i32x8 kf_ = KFR(bf, kb_, s_); Pn[kb_] = mfma8(kf_, q8[s_], (s_) == 0 ? (f32x16){} : Pn[kb_]); PIN1(Pn[kb_]); } while (0)
#define EX(P, h_, r_) do { float t_ = P[h_][r_]; PIN1(t_); t_ = ex2(t_); PIN1(t_); P[h_][r_] = t_; } while (0)
#define CV(P, w_) do { p8[w_] = pk4_fp8s(p8[w_], P[(w_) >> 2][4 * ((w_) & 3)], P[(w_) >> 2][4 * ((w_) & 3) + 1], P[(w_) >> 2][4 * ((w_) & 3) + 2], P[(w_) >> 2][4 * ((w_) & 3) + 3]); PIN1(p8[w_]); } while (0)
#define HALF(Pn, Pc, bfn, bfc, bfKd, bfVd, DOK) do { \
        MF(Pn, 0, 0, bfn); if (DOK) DMA_K0(bfKd); SBAR(); EX(Pc, 1, 0); EX(Pc, 1, 1); EX(Pc, 1, 2); CV(Pc, 0); \
        MF(Pn, 1, 0, bfn); if (DOK) DMA_K1(bfKd); SBAR(); EX(Pc, 1, 3); EX(Pc, 1, 4); EX(Pc, 1, 5); CV(Pc, 1); \
        MF(Pn, 0, 1, bfn); DMA_V(bfVd); SBAR(); EX(Pc, 1, 6); EX(Pc, 1, 7); EX(Pc, 1, 8); CV(Pc, 2); \
        MF(Pn, 1, 1, bfn); EX(Pc, 1, 9); EX(Pc, 1, 10); EX(Pc, 1, 11); CV(Pc, 3); \
        MF(Pn, 0, 2, bfn); EX(Pc, 1, 12); EX(Pc, 1, 13); CV(Pc, 4); CV(Pc, 5); \
        MF(Pn, 1, 2, bfn); EX(Pc, 1, 14); EX(Pc, 1, 15); CV(Pc, 6); CV(Pc, 7); \
        lacc = mfma8(p8, ones8, lacc); PIN1(lacc); EX(Pn, 0, 0); EX(Pn, 0, 1); EX(Pn, 0, 2); \
        { const i32x8 vf_ = VFR(bfc, 0); o[0] = mfma8(p8, vf_, o[0]); PIN1(o[0]); } EX(Pn, 0, 3); EX(Pn, 0, 4); EX(Pn, 0, 5); \
        { const i32x8 vf_ = VFR(bfc, 1); o[1] = mfma8(p8, vf_, o[1]); PIN1(o[1]); } EX(Pn, 0, 6); EX(Pn, 0, 7); EX(Pn, 0, 8); \
        { const i32x8 vf_ = VFR(bfc, 2); o[2] = mfma8(p8, vf_, o[2]); PIN1(o[2]); } EX(Pn, 0, 9); EX(Pn, 0, 10); EX(Pn, 0, 11); \
        { const i32x8 vf_ = VFR(bfc, 3); o[3] = mfma8(p8, vf_, o[3]); PIN1(o[3]); } EX(Pn, 0, 12); EX(Pn, 0, 13); EX(Pn, 0, 14); EX(Pn, 0, 15); \
        TSYNC(); } while (0)
    for (int j = 1; j + 1 < NT; j += 2) {
        HALF(pB, pA, 1, 0, 0, 1, true);
        HALF(pA, pB, 0, 1, 1, 0, true);
    }
    HALF(pB, pA, 1, 0, 0, 1, false);
    FIN0(pB);
    PV(1);
#undef HALF
#undef CV
#undef EX
#undef MF
#undef PIN1
#undef DMA_K
#undef DMA_K0
#undef DMA_K1
#undef DMA_V
#undef TSYNC
#undef KFR
#undef VFR
#undef QKT
#undef PARTIAL
#undef FIND
#undef FIN0
#undef PV
#undef PIN_O
    {
        int ln = threadIdx.x & 63; asm volatile("" : "+v"(ln));
        const int e32 = ln & 31, ehi = ln >> 5;
        float rli[16];
#pragma unroll
        for (int r = 0; r < 16; ++r) rli[r] = __builtin_amdgcn_rcpf(lacc[r]);
        __syncthreads();
        LAS bf16_t* stg = (LAS bf16_t*)(lds + wid * 8704);
#pragma unroll
        for (int r = 0; r < 16; ++r) { const int orow = crow32(r, ehi);
#pragma unroll
            for (int d0 = 0; d0 < 4; ++d0) { const unsigned w = cvt_pk_bf16(o[d0][r] * rli[r], 0.f); stg[orow * 136 + d0 * 32 + e32] = (bf16_t)w; } }
        asm volatile("s_waitcnt lgkmcnt(0)" ::: "memory");
        bf16_t* Ow = T.MIX + (tok0 + qw0) * 2048 + 1024 + h * 128;
#pragma unroll
        for (int i = 0; i < 8; ++i) { const int row = i * 4 + (ln >> 4), ch = ln & 15; const u32x4 v = *(const LAS u32x4*)(stg + row * 136 + ch * 8); *(u32x4*)(Ow + (size_t)row * 2048 + ch * 8) = v; }
        __syncthreads();
    }
}
struct TensorsD8 { const bf16_t* Q; const unsigned char* K8; const unsigned char* VT8; bf16_t* MIX; };
constexpr int D8_OFF_V = 0, D8_VT = 8192, D8_OFF_K = 16384, D8_KT = 8192;
__device__ __forceinline__ void attn_unit_diff8(const TensorsD8& T, int b, int h, int qblk, LAS char* lds, float lam, const float* relb, const float* gsub) {
    constexpr int NT = SEQ / 64;
    int tid = threadIdx.x; asm volatile("" : "+v"(tid));
    const int wid = __builtin_amdgcn_readfirstlane(tid >> 6), lane = tid & 63, r32 = lane & 31, hi = lane >> 5;
    const int rg = wid & 3, comp = wid >> 2;
    const size_t tok0 = (size_t)b * SEQ; const int qw0 = qblk * 128 + rg * 32;
    LAS char* V_lds = lds + D8_OFF_V; LAS char* K_lds = lds + D8_OFF_K;
    LAS float* tbl = (LAS float*)(lds + OFF_TBL);
    i32x8 q8;
    { const bf16_t* Qw = T.Q + (tok0 + qw0 + r32) * 1024 + h * 128 + comp * 64 + 32 * hi; float v[32];
#pragma unroll
      for (int c = 0; c < 4; ++c) { const bf16x8 t = *(const bf16x8*)(Qw + 8 * c);
#pragma unroll
          for (int e = 0; e < 8; ++e) v[8 * c + e] = bf2f((unsigned short)t[e]); }
#pragma unroll
      for (int w = 0; w < 8; ++w) q8[w] = pk4_fp8(v[4 * w], v[4 * w + 1], v[4 * w + 2], v[4 * w + 3]);
    }
    const unsigned char* Kp = T.K8 + tok0 * 1024 + h * 128; const unsigned char* Vp = T.VT8 + ((size_t)(b * 8 + h) * 128) * SEQ;
    int ksoff, vsoff;
    { const int row = 8 * wid + (lane >> 3), c = (lane & 7) ^ ((row >> 1) & 7); ksoff = row * 1024 + 16 * c; }
    { const int d = 16 * wid + (lane >> 2), c = (lane & 3) ^ ((d >> 2) & 3); vsoff = d * SEQ + 16 * c; }
    LAS char* kxa[2]; LAS char* vxa[2];
#pragma unroll
    for (int e = 0; e < 2; ++e) { kxa[e] = K_lds + r32 * 128 + 16 * ((4 * comp + 2 * hi + e) ^ ((r32 >> 1) & 7)); vxa[e] = V_lds + r32 * 64 + 16 * ((2 * hi + e) ^ ((r32 >> 2) & 3)); }
#define DMA_K(bf) do { __builtin_amdgcn_global_load_lds((const unsigned*)(Kp + ksoff), (LAS unsigned*)(K_lds + (bf) * D8_KT + wid * 1024), 16, 0, 0); Kp += 64 * 1024; } while (0)
#define DMA_V(bf) do { __builtin_amdgcn_global_load_lds((const unsigned*)(Vp + vsoff), (LAS unsigned*)(V_lds + (bf) * D8_VT + wid * 1024), 16, 0, 0); Vp += 64; } while (0)
#define TSYNC() do { asm volatile("s_waitcnt vmcnt(0)" ::: "memory"); __syncthreads(); } while (0)
#define KFR(bf, kb) ({ i32x8 f_; const i32x4 lo_ = *(const LAS i32x4*)(kxa[0] + (bf) * D8_KT + (kb) * 32 * 128), hi_ = *(const LAS i32x4*)(kxa[1] + (bf) * D8_KT + (kb) * 32 * 128); \
        f_[0] = lo_[0]; f_[1] = lo_[1]; f_[2] = lo_[2]; f_[3] = lo_[3]; f_[4] = hi_[0]; f_[5] = hi_[1]; f_[6] = hi_[2]; f_[7] = hi_[3]; f_; })
#define VFR(bf, db) ({ i32x8 f_; const i32x4 lo_ = *(const LAS i32x4*)(vxa[0] + (bf) * D8_VT + (db) * 32 * 64), hi_ = *(const LAS i32x4*)(vxa[1] + (bf) * D8_VT + (db) * 32 * 64); \
        f_[0] = lo_[0]; f_[1] = lo_[1]; f_[2] = lo_[2]; f_[3] = lo_[3]; f_[4] = hi_[0]; f_[5] = hi_[1]; f_[6] = hi_[2]; f_[7] = hi_[3]; f_; })
    const float blneg = relb[15 * 8 + h] * LOG2E, blpos = relb[31 * 8 + h] * LOG2E; int curcls;
    if (tid < 384) { const int rel = tid - 192, n = rel < 0 ? -rel : rel; int bk;
        if (n < 8) bk = n; else { const int lg = 31 - __builtin_clz((unsigned)(n * n)); bk = 2 + lg; if (bk > 15) bk = 15; }
        if (rel > 0) bk += 16;
        tbl[tid] = relb[bk * 8 + h] * LOG2E; }
#define CLS(j) ((64 * (j) - qw0) <= -154 ? 0 : ((64 * (j) - qw0) >= 122 ? 2 : 1))
#define BLC(c) ((c) == 0 ? blneg : ((c) == 2 ? blpos : 0.f))
    curcls = CLS(0);
    f32x16 o[4] = {}, lacc = {}; f32x16 pA[2], pB[2]; i32x8 p8 = {};
    const i32x8 ones8 = {0x38383838, 0x38383838, 0x38383838, 0x38383838, 0x38383838, 0x38383838, 0x38383838, 0x38383838};
#define PIN1(x) asm volatile("" : "+v"(x))
#define MFK(Pn, kb_, kf_) do { Pn[kb_] = mfma8(kf_, q8, (f32x16){}); PIN1(Pn[kb_]); } while (0)
#define EX(P, h_, r_) do { float t_ = P[h_][r_]; PIN1(t_); t_ = ex2(t_); PIN1(t_); P[h_][r_] = t_; } while (0)
#define CV(P, w_) do { p8[w_] = pk4_fp8s(p8[w_], P[(w_) >> 2][4 * ((w_) & 3)], P[(w_) >> 2][4 * ((w_) & 3) + 1], P[(w_) >> 2][4 * ((w_) & 3) + 2], P[(w_) >> 2][4 * ((w_) & 3) + 3]); PIN1(p8[w_]); } while (0)
#define NEAR(P, j) do { if (CLS(j) == 1) { const LAS float* tp_ = tbl + (64 * (j) - qw0 - r32 + 4 * hi + 192); \
            _Pragma("unroll") for (int kb_ = 0; kb_ < 2; ++kb_) _Pragma("unroll") for (int r_ = 0; r_ < 16; ++r_) P[kb_][r_] += tp_[32 * kb_ + (r_ & 3) + 8 * (r_ >> 2)]; SBAR(); } } while (0)
#define RESC(j) do { const int c_ = CLS(j); if (c_ != curcls) { const float f_ = ex2(BLC(curcls) - BLC(c_)); curcls = c_; lacc *= f_; _Pragma("unroll") for (int d_ = 0; d_ < 4; ++d_) o[d_] *= f_; } } while (0)
#define HALF(Pn, Pc, bfn, bfc, bfKd, bfVd, DOK, jn) do { \
        if (DOK) DMA_K(bfKd); DMA_V(bfVd); SBAR(); \
        i32x8 fa_ = KFR(bfn, 0), fb_ = KFR(bfn, 1); \
        MFK(Pn, 0, fa_); fa_ = VFR(bfc, 0); EX(Pc, 1, 0); EX(Pc, 1, 1); EX(Pc, 1, 2); EX(Pc, 1, 3); CV(Pc, 0); CV(Pc, 1); \
        MFK(Pn, 1, fb_); fb_ = VFR(bfc, 1); EX(Pc, 1, 4); EX(Pc, 1, 5); EX(Pc, 1, 6); EX(Pc, 1, 7); CV(Pc, 2); CV(Pc, 3); \
        EX(Pc, 1, 8); EX(Pc, 1, 9); EX(Pc, 1, 10); EX(Pc, 1, 11); CV(Pc, 4); CV(Pc, 5); CV(Pc, 6); \
        EX(Pc, 1, 12); EX(Pc, 1, 13); EX(Pc, 1, 14); EX(Pc, 1, 15); CV(Pc, 7); \
        NEAR(Pn, jn); \
        lacc = mfma8(p8, ones8, lacc); PIN1(lacc); EX(Pn, 0, 0); EX(Pn, 0, 1); EX(Pn, 0, 2); \
        o[0] = mfma8(p8, fa_, o[0]); PIN1(o[0]); fa_ = VFR(bfc, 2); EX(Pn, 0, 3); EX(Pn, 0, 4); EX(Pn, 0, 5); \
        o[1] = mfma8(p8, fb_, o[1]); PIN1(o[1]); fb_ = VFR(bfc, 3); EX(Pn, 0, 6); EX(Pn, 0, 7); EX(Pn, 0, 8); \
        o[2] = mfma8(p8, fa_, o[2]); PIN1(o[2]); EX(Pn, 0, 9); EX(Pn, 0, 10); EX(Pn, 0, 11); \
        o[3] = mfma8(p8, fb_, o[3]); PIN1(o[3]); EX(Pn, 0, 12); EX(Pn, 0, 13); EX(Pn, 0, 14); EX(Pn, 0, 15); \
        RESC(jn); \
        TSYNC(); } while (0)
    DMA_K(0); TSYNC();
    DMA_K(1); DMA_V(0);
    { const i32x8 fa_ = KFR(0, 0), fb_ = KFR(0, 1); pA[0] = mfma8(fa_, q8, (f32x16){}); pA[1] = mfma8(fb_, q8, (f32x16){}); }
    NEAR(pA, 0);
#pragma unroll
    for (int r = 0; r < 16; ++r) pA[0][r] = ex2(pA[0][r]);
    TSYNC();
    for (int j = 1; j + 1 < NT; j += 2) {
        HALF(pB, pA, 1, 0, 0, 1, true, j);
        HALF(pA, pB, 0, 1, 1, 0, true, j + 1);
    }
    HALF(pB, pA, 1, 0, 0, 1, false, NT - 1);
#pragma unroll
    for (int r = 0; r < 16; ++r) pB[1][r] = ex2(pB[1][r]);
#pragma unroll
    for (int w = 0; w < 8; ++w) p8[w] = pk4_fp8s(p8[w], pB[w >> 2][4 * (w & 3)], pB[w >> 2][4 * (w & 3) + 1], pB[w >> 2][4 * (w & 3) + 2], pB[w >> 2][4 * (w & 3) + 3]);
    lacc = mfma8(p8, ones8, lacc);
#pragma unroll
    for (int db = 0; db < 4; ++db) { const i32x8 vf = VFR(1, db); o[db] = mfma8(p8, vf, o[db]); }
#undef HALF
#undef RESC
#undef NEAR
#undef CV
#undef EX
#undef MFK
#undef PIN1
#undef CLS
#undef BLC
#undef KFR
#undef VFR
#undef DMA_K
#undef DMA_V
#undef TSYNC
    {
        int ln = threadIdx.x & 63; asm volatile("" : "+v"(ln));
        const int e32 = ln & 31, ehi = ln >> 5;
        float rli[16];
#pragma unroll
        for (int r = 0; r < 16; ++r) rli[r] = __builtin_amdgcn_rcpf(lacc[r]);
        __syncthreads();
        LAS float* xch = (LAS float*)(lds + OFF_XCH) + rg * 4096 + ln;
        if (comp == 1) { const float nl = -lam;
#pragma unroll
            for (int d0 = 0; d0 < 4; ++d0)
#pragma unroll
                for (int r = 0; r < 16; ++r) xch[(d0 * 16 + r) * 64] = o[d0][r] * rli[r] * nl; }
        __syncthreads();
        if (comp == 0) {
            float gsv[4];
#pragma unroll
            for (int d0 = 0; d0 < 4; ++d0) gsv[d0] = gsub[d0 * 32 + e32] * 0.8f;
            LAS bf16_t* stg = (LAS bf16_t*)(lds + OFF_STG + rg * 8704);
#pragma unroll
            for (int r = 0; r < 16; ++r) { float v[4]; float ss = 0.f;
#pragma unroll
                for (int d0 = 0; d0 < 4; ++d0) { v[d0] = o[d0][r] * rli[r] + xch[(d0 * 16 + r) * 64]; ss += v[d0] * v[d0]; }
                ss += __shfl_xor(ss, 1); ss += __shfl_xor(ss, 2); ss += __shfl_xor(ss, 4); ss += __shfl_xor(ss, 8); ss += __shfl_xor(ss, 16);
                const float rs = rsq(ss * (1.f / 128.f) + EPS); const int orow = crow32(r, ehi);
#pragma unroll
                for (int d0 = 0; d0 < 4; ++d0) { const unsigned w = cvt_pk_bf16(v[d0] * rs * gsv[d0], 0.f); stg[orow * 136 + d0 * 32 + e32] = (bf16_t)w; } }
            asm volatile("s_waitcnt lgkmcnt(0)" ::: "memory");
            bf16_t* Ow = T.MIX + (tok0 + qw0) * 2048 + h * 128;
#pragma unroll
            for (int i = 0; i < 8; ++i) { const int row = i * 4 + (ln >> 4), ch = ln & 15; const u32x4 v = *(const LAS u32x4*)(stg + row * 136 + ch * 8); *(u32x4*)(Ow + (size_t)row * 2048 + ch * 8) = v; }
        }
        __syncthreads();
    }
}
#undef SBAR
}

constexpr int NWAVES = 8, NPH = 9;
constexpr size_t MiB = 1u << 20;
constexpr size_t WS_CTL = 0, CTL_ZERO_BYTES = 1 * MiB, WS_MOD = 512 * 1024;
constexpr size_t WS_ROPEC = 1 * MiB, WS_ROPES = 1 * MiB + 512 * 1024;
constexpr size_t WS_SSQ_Q = 2 * MiB, WS_SSQ_KV = 2 * MiB + 512 * 1024, WS_SSQ_PE = 2 * MiB + 768 * 1024;
constexpr size_t WS_KR = 3 * MiB;
constexpr size_t WS_WIN = 8 * MiB, WS_WQB = 24 * MiB, WS_WKVB = 26 * MiB, WS_WOUT = 28 * MiB, WS_WGU = 36 * MiB, WS_WDN = 80 * MiB;
constexpr size_t WS_XN = 104 * MiB, WS_MIX = 168 * MiB;
constexpr size_t WS_QD = 232 * MiB, WS_KD = 264 * MiB, WS_VD = 296 * MiB, WS_CQ = 328 * MiB, WS_CKV = 344 * MiB, WS_QM = 352 * MiB, WS_KM = 400 * MiB, WS_VM = 448 * MiB;
constexpr size_t WS_H = 232 * MiB;
constexpr size_t WS_X1B = 408 * MiB;
constexpr size_t WS_END = 480 * MiB;
constexpr int CW_BAR = 4096;
constexpr int RING_OFF = 0, RING_BYTES = 131072, EPI_OFF = 131072, LDSCTL_OFF = 139264, MISC_OFF = LDSCTL_OFF + 320, LDS_BYTES = 147456;

typedef GAS unsigned gu32;
#define RLX_AGENT __ATOMIC_RELAXED, __HIP_MEMORY_SCOPE_AGENT
#define LDS_WAIT() asm volatile("s_waitcnt lgkmcnt(0)" ::: "memory")

#define XB_TMO      128
#define XB_XCNT(j)  (256  + 64 * (j))
#define XB_XSUB(j)  (1280 + 64 * (j))
#define XB_XGEN(j)  (2304 + 64 * (j))
#define XB_TOP      3328
#define XB_TOPGEN   3392
#define XCD_BAR_WORDS 3456
#define XB_SPIN_CAP (1u << 18)
__device__ __forceinline__ unsigned xb_ld(unsigned* p)              { return __hip_atomic_load(p, __ATOMIC_RELAXED, __HIP_MEMORY_SCOPE_AGENT); }
__device__ __forceinline__ unsigned xb_add(unsigned* p, unsigned v) { return __hip_atomic_fetch_add(p, v, __ATOMIC_RELAXED, __HIP_MEMORY_SCOPE_AGENT); }
__device__ __forceinline__ unsigned xb_xcc_id() { return (unsigned)__builtin_amdgcn_s_getreg((3 << 11) | 20) & 0xFu; }
#define XB_SPIN(cond, bar) do { unsigned _sp = 0; while (cond) { __builtin_amdgcn_s_sleep(1); \
    if ((++_sp & 255u) == 0u) { if (xb_ld(&(bar)[XB_TMO])) break; if (_sp > XB_SPIN_CAP) { atomicAdd(&(bar)[XB_TMO], 1u); break; } } } } while (0)
struct XcdBarrier { unsigned* bar; unsigned x; volatile LAS unsigned* st; };
__device__ __forceinline__ XcdBarrier xcd_barrier_post(unsigned* bar, volatile LAS unsigned* st) {
    XcdBarrier b; b.bar = bar; b.x = xb_xcc_id(); b.st = st;
    if (threadIdx.x == 0) (void)xb_add(&bar[XB_XCNT(b.x)], 1u);
    return b;
}
__device__ __forceinline__ void xcd_barrier_complete(unsigned* bar, unsigned x, unsigned& nloc, unsigned& nx) {
    const unsigned G = gridDim.x * gridDim.y * gridDim.z;
    unsigned sum, cnt, mine, sp = 0u;
    for (;;) {
        sum = 0u; cnt = 0u; mine = 0u;
#pragma unroll
        for (unsigned j = 0; j < 16; ++j) { const unsigned c = xb_ld(&bar[XB_XCNT(j)]); sum += c; cnt += (c > 0u) ? 1u : 0u; mine = (j == x) ? c : mine; }
        if (sum == G) break;
        __builtin_amdgcn_s_sleep(1);
        if ((++sp & 255u) == 0u) { if (xb_ld(&bar[XB_TMO])) break; if (sp > XB_SPIN_CAP) { atomicAdd(&bar[XB_TMO], 1u); break; } }
    }
    nloc = mine > 0u ? mine : 1u; nx = cnt > 0u ? cnt : 1u;
}
__device__ __forceinline__ void xcd_barrier(const XcdBarrier& b) {
    asm volatile("s_waitcnt vmcnt(0)" ::: "memory");
    __syncthreads();
    if (threadIdx.x == 0) {
        unsigned* bar = b.bar;
        __builtin_amdgcn_s_waitcnt(0);
        unsigned nloc = b.st[0], nx = b.st[1];
        if (nloc == 0u) { xcd_barrier_complete(bar, b.x, nloc, nx); b.st[0] = nloc; b.st[1] = nx; }
        const unsigned old = xb_add(&bar[XB_XSUB(b.x)], 1u);
        const unsigned gen = old / nloc;
        if (old + 1u == (gen + 1u) * nloc) {
            __builtin_amdgcn_fence(__ATOMIC_RELEASE, "agent");
            asm volatile("s_waitcnt vmcnt(0)" ::: "memory");
            const unsigned og = xb_add(&bar[XB_TOP], 1u);
            const unsigned tg = og / nx;
            if (og + 1u == (tg + 1u) * nx) xb_add(&bar[XB_TOPGEN], 1u);
            else XB_SPIN(xb_ld(&bar[XB_TOPGEN]) == tg, bar);
            __builtin_amdgcn_fence(__ATOMIC_ACQUIRE, "agent");
            xb_add(&bar[XB_XGEN(b.x)], 1u);
            asm volatile("s_waitcnt vmcnt(0)" ::: "memory");
        } else {
            XB_SPIN(xb_ld(&bar[XB_XGEN(b.x)]) == gen, bar);
            __builtin_amdgcn_fence(__ATOMIC_ACQUIRE, "agent");
            asm volatile("s_waitcnt vmcnt(0)" ::: "memory");
        }
    }
    __syncthreads();
}

__device__ __forceinline__ float wave_sum(float v) {
#pragma unroll
    for (int o = 1; o < 64; o <<= 1) v += __shfl_xor(v, o);
    return v;
}

enum RowMap { RM_ID = 0, RM_G64 = 1, RM_QB = 2, RM_GATE = 3, RM_UP = 4, RM_P32 = 5 };
__device__ __forceinline__ int rowmap(int kind, int n) {
    switch (kind) {
        case RM_G64:  return (n & ~255) + pmap256(n & 255);
        case RM_QB:   { const int hh = n / 192, d = n - hh * 192; return hh * 256 + pmap256(d); }
        case RM_GATE: return (n >> 7) * 256 + pmap128(n & 127);
        case RM_UP:   return (n >> 7) * 256 + 128 + pmap128(n & 127);
        case RM_P32:  return (n & ~31) + 16 * ((n >> 2) & 1) + 4 * ((n >> 3) & 3) + (n & 3);
        default:      return n;
    }
}
__device__ __forceinline__ void p0_transpose_item(const float* W, int K, int N, bf16_t* WT, int kind, const float* kscale, LAS float* scr, int item, int lane) {
    const int nblk = N / 32, kb = item / nblk, nb = item % nblk, k0 = 64 * kb, n0 = 32 * nb;
    f32x4 t[8];
#pragma unroll
    for (int i = 0; i < 8; ++i) t[i] = __builtin_nontemporal_load((const f32x4*)(W + (size_t)(k0 + 8 * i + (lane >> 3)) * N + n0 + 4 * (lane & 7)));
    LAS char* tl = (LAS char*)scr;
#pragma unroll
    for (int i = 0; i < 8; ++i) { const int kk = 8 * i + (lane >> 3); f32x4 v = t[i]; if (kscale) v = v * kscale[k0 + kk];
        u32x2 w; w.x = cvt_pk_bf16(v[0], v[1]); w.y = cvt_pk_bf16(v[2], v[3]); *(LAS u32x2*)(tl + kk * 64 + 8 * (lane & 7)) = w; }
    LDS_WAIT(); asm volatile("" ::: "memory");
    const int g = lane >> 4, i16 = lane & 15, q = i16 >> 2, p = i16 & 3;
    const int ra = (int)(uintptr_t)tl + (8 * (g >> 1) + q) * 64 + 32 * (g & 1) + 8 * p;
    bf16_t* dst = WT + (size_t)rowmap(kind, n0 + 16 * (g & 1) + i16) * K + k0 + 8 * (g >> 1);
    s16x4 lo[4], hi[4];
#pragma unroll
    for (int j = 0; j < 4; ++j) { asm volatile("ds_read_b64_tr_b16 %0, %1 offset:%2" : "=&v"(lo[j]) : "v"(ra), "i"(j * 1024) : "memory");
                                  asm volatile("ds_read_b64_tr_b16 %0, %1 offset:%2" : "=&v"(hi[j]) : "v"(ra), "i"(j * 1024 + 256) : "memory"); }
    asm volatile("s_waitcnt lgkmcnt(0)" : "+v"(lo[0]), "+v"(lo[1]), "+v"(lo[2]), "+v"(lo[3]), "+v"(hi[0]), "+v"(hi[1]), "+v"(hi[2]), "+v"(hi[3]) :: "memory");
#pragma unroll
    for (int j = 0; j < 4; ++j) { const bf16x8 o = {lo[j][0], lo[j][1], lo[j][2], lo[j][3], hi[j][0], hi[j][1], hi[j][2], hi[j][3]}; *(bf16x8*)(dst + 16 * j) = o; }
    asm volatile("" ::: "memory");
}
__device__ __forceinline__ void p0_ada_item(const float* cvec, const float* w_ada, const float* b_ada, float* MOD, LAS float* cs, int item, int lane) {
    const int cg = item % 192, kc = item / 192, c0 = cg * 64, k0 = kc * 64;
    { f32x4 a;
#pragma unroll
      for (int b = 0; b < 4; ++b) { const float v = cvec[b * DM + k0 + lane]; a[b] = v * __builtin_amdgcn_rcpf(1.f + ex2(-v * LOG2E)); }
      *(LAS f32x4*)(cs + lane * 4) = a; }
    LDS_WAIT(); asm volatile("" ::: "memory");
    f32x4 acc[4] = {};
    const float* wp = w_ada + (size_t)(k0 + (lane >> 4)) * MODW + c0 + 4 * (lane & 15);
    f32x4 w[16];
#pragma unroll
    for (int i = 0; i < 16; ++i) w[i] = __builtin_nontemporal_load((const f32x4*)(wp + (size_t)(4 * i) * MODW));
#pragma unroll
    for (int i = 0; i < 16; ++i) { const f32x4 cb = *(const LAS f32x4*)(cs + (4 * i + (lane >> 4)) * 4);
#pragma unroll
        for (int b = 0; b < 4; ++b) acc[b] += w[i] * cb[b]; }
#pragma unroll
    for (int b = 0; b < 4; ++b)
#pragma unroll
        for (int e = 0; e < 4; ++e) { float v = acc[b][e]; v += __shfl_xor(v, 16); v += __shfl_xor(v, 32); acc[b][e] = v; }
    if (lane < 16) {
        const int col = c0 + 4 * lane;
#pragma unroll
        for (int b = 0; b < 4; ++b)
#pragma unroll
            for (int e = 0; e < 4; ++e) { float v = acc[b][e]; if (kc == 0) v += b_ada[col + e]; atomicAdd(MOD + b * MODW + col + e, v); }
    }
    LDS_WAIT(); asm volatile("" ::: "memory");
}
template <typename TIN>
__device__ __forceinline__ void modnorm_rows8(const TIN* xrows, const float* g, const float* sh, const float* sc, bf16_t* orows, int lane) {
    f32x4 gs[4][2], hs[4][2];
#pragma unroll
    for (int j = 0; j < 4; ++j)
#pragma unroll
        for (int h2 = 0; h2 < 2; ++h2) { const int col = 8 * (lane + 64 * j) + 4 * h2; gs[j][h2] = *(const f32x4*)(g + col) * (*(const f32x4*)(sc + col) + 1.f); hs[j][h2] = *(const f32x4*)(sh + col); }
#pragma unroll 2
    for (int r = 0; r < 8; ++r) {
        f32x4 v[4][2]; float s = 0.f;
        if constexpr (sizeof(TIN) == 4) {
#pragma unroll
            for (int j = 0; j < 4; ++j)
#pragma unroll
                for (int h2 = 0; h2 < 2; ++h2) v[j][h2] = *(const f32x4*)((const float*)xrows + (size_t)r * DM + 8 * (lane + 64 * j) + 4 * h2);
        } else {
            bf16x8 q[4];
#pragma unroll
            for (int j = 0; j < 4; ++j) q[j] = *(const bf16x8*)((const bf16_t*)xrows + (size_t)r * DM + 8 * (lane + 64 * j));
#pragma unroll
            for (int j = 0; j < 4; ++j)
#pragma unroll
                for (int h2 = 0; h2 < 2; ++h2)
#pragma unroll
                    for (int e = 0; e < 4; ++e) v[j][h2][e] = bf2f((unsigned short)q[j][4 * h2 + e]);
        }
#pragma unroll
        for (int j = 0; j < 4; ++j)
#pragma unroll
            for (int h2 = 0; h2 < 2; ++h2) { const f32x4 x = v[j][h2]; s += (x[0] * x[0] + x[1] * x[1]) + (x[2] * x[2] + x[3] * x[3]); }
        const float rs = rsq(wave_sum(s) * (1.f / DM) + EPS);
#pragma unroll
        for (int j = 0; j < 4; ++j) { const f32x4 y0 = v[j][0] * rs * gs[j][0] + hs[j][0], y1 = v[j][1] * rs * gs[j][1] + hs[j][1];
            u32x4 w; w.x = cvt_pk_bf16(y0[0], y0[1]); w.y = cvt_pk_bf16(y0[2], y0[3]); w.z = cvt_pk_bf16(y1[0], y1[1]); w.w = cvt_pk_bf16(y1[2], y1[3]);
            *(u32x4*)(orows + (size_t)r * DM + 8 * (lane + 64 * j)) = w; }
    }
}

struct Args { const float* in[22]; float* out; unsigned char* ws; int ph_lo, ph_hi; };

__global__ void __launch_bounds__(NWAVES * 64, 2) mk_fwd(Args args) {
    extern __shared__ __attribute__((aligned(16))) unsigned char lds_raw[];
    LAS unsigned char* lds = (LAS unsigned char*)lds_raw;
    volatile LAS unsigned* MISC = (volatile LAS unsigned*)(lds + MISC_OFF);
    const int tid = threadIdx.x, lane = tid & 63, wave = __builtin_amdgcn_readfirstlane(tid >> 6);
    const int G = gridDim.x; const int bx = blockIdx.x; const int vcu = (G % 8 == 0) ? (bx % 8) * (G / 8) + bx / 8 : bx;
    unsigned char* ws = args.ws;
    gu32* ctl = (gu32*)(ws + WS_CTL);
    const float* x = args.in[0]; const float* cvec = args.in[1]; const float* relb = args.in[2]; const float* w_ada = args.in[3]; const float* b_ada = args.in[4];
    const float* g_norm1 = args.in[5]; const float* w_in = args.in[6]; const float* g_q_diff = args.in[7]; const float* g_k_diff = args.in[8]; const float* lambda_vecs = args.in[9];
    const float* g_subln = args.in[10]; const float* g_q_a = args.in[11]; const float* w_q_b = args.in[12]; const float* g_kv_a = args.in[13]; const float* w_kv_b = args.in[14];
    const float* g_q_mla = args.in[15]; const float* g_k_mla = args.in[16]; const float* w_out = args.in[17]; const float* g_norm2 = args.in[18];
    const float* w_gate = args.in[19]; const float* w_up = args.in[20]; const float* w_down = args.in[21];
    float* out = args.out;
    float* MOD = (float*)(ws + WS_MOD); float* ROPEC = (float*)(ws + WS_ROPEC); float* ROPES = (float*)(ws + WS_ROPES);
    float* SSQ_Q = (float*)(ws + WS_SSQ_Q); float* SSQ_KV = (float*)(ws + WS_SSQ_KV); float* SSQ_PE = (float*)(ws + WS_SSQ_PE); float* KR = (float*)(ws + WS_KR);
    bf16_t* WIN_T = (bf16_t*)(ws + WS_WIN); bf16_t* WQB_T = (bf16_t*)(ws + WS_WQB); bf16_t* WKVB_T = (bf16_t*)(ws + WS_WKVB); bf16_t* WOUT_T = (bf16_t*)(ws + WS_WOUT);
    bf16_t* WGU_T = (bf16_t*)(ws + WS_WGU); bf16_t* WDN_T = (bf16_t*)(ws + WS_WDN);
    bf16_t* XN = (bf16_t*)(ws + WS_XN); bf16_t* MIX = (bf16_t*)(ws + WS_MIX);
    bf16_t* QD = (bf16_t*)(ws + WS_QD); bf16_t* KD = (bf16_t*)(ws + WS_KD); bf16_t* VD = (bf16_t*)(ws + WS_VD); bf16_t* CQ = (bf16_t*)(ws + WS_CQ); bf16_t* CKV = (bf16_t*)(ws + WS_CKV);
    bf16_t* QM = (bf16_t*)(ws + WS_QM); bf16_t* KM = (bf16_t*)(ws + WS_KM); bf16_t* VM = (bf16_t*)(ws + WS_VM); bf16_t* HB = (bf16_t*)(ws + WS_H); bf16_t* X1B = (bf16_t*)(ws + WS_X1B);

    for (int u = tid; u < (LDS_BYTES - LDSCTL_OFF) / 4; u += NWAVES * 64) ((LAS unsigned*)(lds + LDSCTL_OFF))[u] = 0u;
    __syncthreads();
    XcdBarrier bar; bar.bar = (unsigned*)(ctl + CW_BAR); bar.x = 0; bar.st = nullptr;
    if (MK_LAUNCHES == 1) bar = xcd_barrier_post((unsigned*)(ctl + CW_BAR), MISC + 8);
    const int lo = args.ph_lo, hi = args.ph_hi;
#ifndef PHMASK
#define PHMASK 0x1ff
#endif
#define IN(k) (((PHMASK >> (k)) & 1) && lo <= (k) && (k) < hi)
#define SEAM(k) do { if (IN(k) && IN((k) + 1)) xcd_barrier(bar); } while (0)
    LAS float* EPIP = (LAS float*)(lds + EPI_OFF);

    if (IN(0)) {
        LAS float* scr = (LAS float*)(lds + RING_OFF + wave * 16384);
        const int gw = wave * G + vcu, NGW = G * NWAVES;
        constexpr int I_ADA = 192 * 32, I_IN = (DM / 64) * (INC / 32), I_QB = (512 / 64) * (1536 / 32), I_KVB = (256 / 64) * (2048 / 32), I_OUT = (DM / 64) * (DM / 32),
                      I_G = (DM / 64) * (DFF / 32), I_DN = (DFF / 64) * (DM / 32), I_ZERO = 192 + 512, I_ROPE = SEQ * 32 / 64;
        constexpr int NITEMS = I_ADA + I_IN + I_QB + I_KVB + I_OUT + 2 * I_G + I_DN + I_ZERO + I_ROPE;
        for (int it = gw; it < NITEMS; it += NGW) {
            int r = it;
            if (r < I_ADA) { p0_ada_item(cvec, w_ada, b_ada, MOD, scr, r, lane); continue; } r -= I_ADA;
            if (r < I_IN) { p0_transpose_item(w_in, DM, INC, WIN_T, RM_G64, nullptr, scr, r, lane); continue; } r -= I_IN;
            if (r < I_QB) { p0_transpose_item(w_q_b, 512, 1536, WQB_T, RM_QB, g_q_a, scr, r, lane); continue; } r -= I_QB;
            if (r < I_KVB) { p0_transpose_item(w_kv_b, 256, 2048, WKVB_T, RM_G64, g_kv_a, scr, r, lane); continue; } r -= I_KVB;
            if (r < I_OUT) { p0_transpose_item(w_out, DM, DM, WOUT_T, RM_P32, nullptr, scr, r, lane); continue; } r -= I_OUT;
            if (r < I_G) { p0_transpose_item(w_gate, DM, DFF, WGU_T, RM_GATE, nullptr, scr, r, lane); continue; } r -= I_G;
            if (r < I_G) { p0_transpose_item(w_up, DM, DFF, WGU_T, RM_UP, nullptr, scr, r, lane); continue; } r -= I_G;
            if (r < I_DN) { p0_transpose_item(w_down, DFF, DM, WDN_T, RM_P32, nullptr, scr, r, lane); continue; } r -= I_DN;
            if (r < I_ZERO) {
                if (r < 192) { bf16_t* p = WIN_T + (size_t)rowmap(RM_G64, INC + r) * DM;
#pragma unroll
                    for (int j = 0; j < 4; ++j) *(u32x4*)(p + (lane + 64 * j) * 8) = (u32x4){0u, 0u, 0u, 0u}; }
                else { const int q = r - 192, hh = q >> 6, d = 192 + (q & 63); bf16_t* p = WQB_T + (size_t)(hh * 256 + pmap256(d)) * 512; *(u32x4*)(p + lane * 8) = (u32x4){0u, 0u, 0u, 0u}; }
                continue; } r -= I_ZERO;
            {
                const int e = 64 * r + lane, pos = e >> 5, i = e & 31;
                double inv = 1.0; for (int t = 0; t < i; ++t) inv *= 0.7498942093324559;
                double rev = (double)pos * inv * 0.15915494309189535; rev -= (double)(long long)rev;
                ROPEC[e] = __builtin_amdgcn_cosf((float)rev); ROPES[e] = __builtin_amdgcn_sinf((float)rev);
            }
        }
        SEAM(0);
    }
    if (IN(1)) {
        const int gw = vcu * NWAVES + wave, NGW = G * NWAVES;
        for (int m = 8 * gw; m < M; m += 8 * NGW) { const int b = m >> 12; modnorm_rows8<float>(x + (size_t)m * DM, g_norm1, MOD + b * MODW, MOD + b * MODW + DM, XN + (size_t)m * DM, lane); }
        SEAM(1);
    }
    if (IN(2)) {
        pg8::Gemm g{XN, WIN_T, M, INP, DM}; pg8::StaticOrder S; S.init(M, INP, G, bx);
        EpiProj E{QD, KD, VD, CQ, CKV, SSQ_Q, SSQ_KV, SSQ_PE, KR, g_q_diff, g_k_diff, g_k_mla, ROPEC, ROPES};
        pg8::gemm_phase(lds + RING_OFF, g, S, E);
        SEAM(2);
    }
    if (IN(3)) {
        { pg8::Gemm g{CQ, WQB_T, M, 2048, 512}; pg8::StaticOrder S; S.init(M, 2048, G, bx);
          EpiQ E{QM, SSQ_Q, g_q_mla, ROPEC, ROPES, EPIP};
          pg8::gemm_phase(lds + RING_OFF, g, S, E); }
        { pg8::Gemm g{CKV, WKVB_T, M, 2048, 256}; pg8::StaticOrder S; S.init(M, 2048, G, bx);
          EpiKV E{ws + WS_XN, ws + WS_XN + 40 * MiB, SSQ_KV, SSQ_PE, KR, g_k_mla, EPIP};
          pg8::gemm_phase(lds + RING_OFF, g, S, E); }
        SEAM(3);
    }
    if (IN(4)) {
        float d01 = 0.f, d23 = 0.f;
        for (int i = 0; i < 64; ++i) { d01 += lambda_vecs[i] * lambda_vecs[64 + i]; d23 += lambda_vecs[128 + i] * lambda_vecs[192 + i]; }
        const float lam = __expf(d01) - __expf(d23) + 0.2f;
#ifndef ATT_MASK
#define ATT_MASK 3
#endif
        unsigned char* K8 = ws + WS_XN; unsigned char* VT8 = ws + WS_XN + 40 * MiB;
        unsigned char* KD8 = (unsigned char*)KD; unsigned char* VTD8 = (unsigned char*)VD;
        if (ATT_MASK & 1) { att::TensorsD8 T{QD, KD8, VTD8, MIX};
          for (int uu = vcu; uu < BATCH * 8 * 32; uu += G) { const int bh = uu >> 5, qb = uu & 31, hh = bh & 7;
              att::attn_unit_diff8(T, bh >> 3, hh, qb, (LAS char*)(lds + RING_OFF), lam, relb, g_subln); } }
        if (ATT_MASK & 2) { att::Tensors8 T{QM, K8, VT8, MIX, ROPEC, ROPES};
          for (int uu = vcu; uu < BATCH * 8 * 16; uu += G) { const int bh = uu >> 4, qb = uu & 15;
              att::attn_unit_mla8(T, bh >> 3, bh & 7, qb, (LAS char*)(lds + RING_OFF)); } }
        SEAM(4);
    }
    if (IN(5)) {
        pg8::Gemm g{MIX, WOUT_T, M, DM, DM}; pg8::StaticOrder S; S.init(M, DM, G, bx);
        EpiRes1 E{x, MOD + 2 * DM, X1B};
        pg8::gemm_phase(lds + RING_OFF, g, S, E);
        SEAM(5);
    }
    if (IN(6)) {
        const int gw = vcu * NWAVES + wave, NGW = G * NWAVES;
        for (int m = 8 * gw; m < M; m += 8 * NGW) { const int b = m >> 12; modnorm_rows8<bf16_t>(X1B + (size_t)m * DM, g_norm2, MOD + b * MODW + 3 * DM, MOD + b * MODW + 4 * DM, XN + (size_t)m * DM, lane); }
        SEAM(6);
    }
    if (IN(7)) {
        pg8::Gemm g{XN, WGU_T, M, 2 * DFF, DM}; pg8::StaticOrder S; S.init(M, 2 * DFF, G, bx);
        EpiSwiglu E{HB};
        pg8::gemm_phase(lds + RING_OFF, g, S, E);
        SEAM(7);
    }
    if (IN(8)) {
        pg8::Gemm g{HB, WDN_T, M, DM, DFF}; pg8::StaticOrder S; S.init(M, DM, G, bx);
        EpiRes2 E{X1B, MOD + 5 * DM, out};
        pg8::gemm_phase(lds + RING_OFF, g, S, E);
    }
#undef IN
#undef SEAM
}

extern "C" void kernel_launch(void* const* d_in, const int* in_sizes, int n_in, void* d_out, int out_size, void* d_ws, size_t ws_size, hipStream_t stream) {
    static int grid = 0;
    if (grid == 0) {
        if (n_in != 22 || in_sizes[0] != M * DM || out_size != M * DM || ws_size < WS_END) { fprintf(stderr, "kernel_launch: unexpected shapes (n_in %d, in0 %d, out %d, ws %zu)\n", n_in, n_in > 0 ? in_sizes[0] : -1, out_size, ws_size); grid = -1; return; }
        int dev = 0, cus = 0, per_cu = 0;
        if (hipGetDevice(&dev) != hipSuccess || hipDeviceGetAttribute(&cus, hipDeviceAttributeMultiprocessorCount, dev) != hipSuccess) { grid = -1; return; }
        if (hipFuncSetAttribute((const void*)mk_fwd, hipFuncAttributeMaxDynamicSharedMemorySize, LDS_BYTES) != hipSuccess) { fprintf(stderr, "kernel_launch: hipFuncSetAttribute failed\n"); grid = -1; return; }
        if (hipOccupancyMaxActiveBlocksPerMultiprocessor(&per_cu, (const void*)mk_fwd, NWAVES * 64, LDS_BYTES) != hipSuccess || per_cu < 1) { fprintf(stderr, "kernel_launch: occupancy query says %d\n", per_cu); per_cu = 1; }
        (void)hipGetLastError();
        grid = cus;
    }
    if (grid < 0) return;
    (void)hipMemsetAsync((char*)d_ws + WS_CTL, 0, CTL_ZERO_BYTES, stream);
    Args a{};
    for (int i = 0; i < 22; ++i) a.in[i] = (const float*)d_in[i];
    a.out = (float*)d_out; a.ws = (unsigned char*)d_ws;
    for (int li = 0; li < MK_LAUNCHES; ++li) {
        a.ph_lo = (MK_LAUNCHES == 1) ? 0 : li; a.ph_hi = (MK_LAUNCHES == 1) ? NPH : li + 1;
        hipLaunchKernelGGL(mk_fwd, dim3(grid), dim3(NWAVES * 64), LDS_BYTES, stream, a);
    }
    const hipError_t le = hipPeekAtLastError();
    if (le != hipSuccess) fprintf(stderr, "kernel_launch: launch failed: %s\n", hipGetErrorName(le));
}
```

```cpp
#include <hip/hip_runtime.h>
#include <cstdio>
#include <cstdint>

#ifndef MK_LAUNCHES
#define MK_LAUNCHES 1
#endif

#define LAS __attribute__((address_space(3)))
#define GAS __attribute__((address_space(1)))
typedef unsigned short bf16_t;
typedef short bf16x8 __attribute__((ext_vector_type(8)));
typedef short s16x4 __attribute__((ext_vector_type(4)));
typedef float f32x4 __attribute__((ext_vector_type(4)));
typedef float f32x2 __attribute__((ext_vector_type(2)));
typedef float f32x16 __attribute__((ext_vector_type(16)));
typedef unsigned u32x4 __attribute__((ext_vector_type(4)));
typedef unsigned u32x2 __attribute__((ext_vector_type(2)));

constexpr int BATCH = 4, SEQ = 4096, DM = 2048, M = BATCH * SEQ, DFF = 5632, INC = 3904, INP = 4096, MODW = 6 * DM;
constexpr float EPS = 1e-6f, LOG2E = 1.4426950408889634f;
constexpr float QD_SCALE = 0.125f * LOG2E;
constexpr float QM_SCALE = 0.07216878364870322f * LOG2E;

typedef __bf16 bf16x2n_t __attribute__((ext_vector_type(2)));
typedef float f32x2n_t __attribute__((ext_vector_type(2)));
__device__ __forceinline__ unsigned cvt_pk_bf16_ord(float lo, float hi) { unsigned r; asm volatile("v_cvt_pk_bf16_f32 %0, %1, %2" : "=v"(r) : "v"(lo), "v"(hi)); return r; }
__device__ __forceinline__ unsigned cvt_pk_bf16(float lo, float hi) { const f32x2n_t v = {lo, hi}; const bf16x2n_t b = __builtin_convertvector(v, bf16x2n_t); return __builtin_bit_cast(unsigned, b); }
__device__ __forceinline__ int pk4_fp8(float a, float b, float c, float d) { int r = 0; r = __builtin_amdgcn_cvt_pk_fp8_f32(a, b, r, false); r = __builtin_amdgcn_cvt_pk_fp8_f32(c, d, r, true); return r; }
__device__ __forceinline__ float rsq(float x) { return __builtin_amdgcn_rsqf(x); }
__device__ __forceinline__ float ex2(float x) { return __builtin_amdgcn_exp2f(x); }

namespace pg8 {
constexpr int BM = 256, BK = 64, HALF = 128, HTB = HALF * BK * 2, STAGE_BYTES = 8 * HTB, NXCD = 8, WGM = 4;
__host__ __device__ __forceinline__ int lds_byte(int r, int c) { const int st = (r >> 4) * 2 + (c >> 5), rr = r & 15, cc = c & 31, ob = rr * 64 + cc * 2; return st * 1024 + (ob ^ (((ob >> 9) & 1) << 5)); }
__host__ __device__ __forceinline__ void stage_rc(int b, int& R, int& C) { const int st = b / 1024, sb = b % 1024, swz = sb ^ (((sb >> 9) & 1) << 5); R = (st >> 1) * 16 + swz / 64; C = (st & 1) * 32 + (swz % 64) / 2; }
struct Unit { int pm, pn; };
struct Gemm { const bf16_t* A; const bf16_t* Bt; int M, N, K; };
struct StaticOrder {
    int nM, nN, nwg, G, c;
    __host__ __device__ void init(int M_, int N_, int G_, int c_) { nM = M_ / BM; nN = N_ / BM; nwg = nM * nN; G = G_; c = c_; }
    __host__ __device__ bool next(int i, Unit& u) const {
        const long L = (long)i * G + c; if (L >= nwg) return false;
        int wgid = (int)L; { const int q = nwg / NXCD, r = nwg % NXCD, xcd = wgid % NXCD, off = wgid / NXCD; wgid = (xcd < r ? xcd * (q + 1) : r * (q + 1) + (xcd - r) * q) + off; }
        const int nig = WGM * nN, gid = wgid / nig, fm = gid * WGM, gsz = (nM - fm) < WGM ? (nM - fm) : WGM;
        u.pm = fm + ((wgid % nig) % gsz); u.pn = (wgid % nig) / gsz; return true;
    }
};
typedef f32x4 Acc[2][2][4][2];

template <class Epi>
__device__ __forceinline__ void gemm_phase(LAS unsigned char* lds, const Gemm g, const StaticOrder& S, const Epi& E) {
    int tid = threadIdx.x; asm volatile("" : "+v"(tid));
    const int wid = __builtin_amdgcn_readfirstlane(tid >> 6), lane = tid & 63, wr = wid >> 2, wc = wid & 3, fr = lane & 15, fq = lane >> 4;
    const int K = g.K, nt = K / BK;
    unsigned voffA[2];
#pragma unroll
    for (int i = 0; i < 2; ++i) { int R, C; stage_rc(tid * 16 + i * 8192, R, C); voffA[i] = (unsigned)(R * K + C) * 2u; }
    const size_t kstep = (size_t)(BK * 2);
    const size_t hstep = (size_t)HALF * K * 2;
    const size_t tstep = 2 * hstep;
    const unsigned ldsw = (unsigned)wid * 1024u;
    const int aoff = lds_byte(wr * 64 + fr, fq * 8), boff = lds_byte(wc * 32 + fr, fq * 8);
#define PG8_SA(b, h) (((b) * 2 + (h)) * HTB)
#define PG8_SB(b, h) ((4 + (b) * 2 + (h)) * HTB)
#define PG8_STAGE(bufoff, gbase, voff) do { _Pragma("unroll") for (int _i = 0; _i < 2; ++_i) \
        __builtin_amdgcn_global_load_lds((const unsigned*)((const char*)(gbase) + (voff)[_i]), (LAS unsigned*)(lds + (bufoff) + ldsw + _i * 8192), 16, 0, 0); } while (0)
#define PG8_LDA(dst, b, h) do { _Pragma("unroll") for (int m = 0; m < 4; ++m) _Pragma("unroll") for (int k = 0; k < 2; ++k) dst[m][k] = *(const LAS bf16x8*)(lds + PG8_SA(b, h) + aoff + m * 2048 + k * 1024); } while (0)
#define PG8_LDB(dst, b, h) do { _Pragma("unroll") for (int n = 0; n < 2; ++n) _Pragma("unroll") for (int k = 0; k < 2; ++k) dst[n][k] = *(const LAS bf16x8*)(lds + PG8_SB(b, h) + boff + n * 2048 + k * 1024); } while (0)
#define PG8_MMA(ai, bj, At, Bt) do { __builtin_amdgcn_s_setprio(1); _Pragma("unroll") for (int m = 0; m < 4; ++m) _Pragma("unroll") for (int n = 0; n < 2; ++n) _Pragma("unroll") for (int k = 0; k < 2; ++k) \
        acc[ai][bj][m][n] = __builtin_amdgcn_mfma_f32_16x16x32_bf16(Bt[n][k], At[m][k], acc[ai][bj][m][n], 0, 0, 0); __builtin_amdgcn_s_setprio(0); } while (0)
#define PG8_WAIT_V(n) asm volatile("s_waitcnt vmcnt(" #n ")" ::: "memory")
#define PG8_WAIT_L(n) asm volatile("s_waitcnt lgkmcnt(" #n ")" ::: "memory")
#define PG8_BAR __builtin_amdgcn_s_barrier()
#define PG8_SCHED __builtin_amdgcn_sched_barrier(0)
    Unit cur, nxt; int ui = 0;
    if (!S.next(0, cur)) return;
    Acc acc;
#pragma unroll
    for (int a = 0; a < 2; ++a)
#pragma unroll
        for (int b = 0; b < 2; ++b)
#pragma unroll
            for (int m = 0; m < 4; ++m)
#pragma unroll
                for (int n = 0; n < 2; ++n) acc[a][b][m][n] = (f32x4){0.f, 0.f, 0.f, 0.f};
    bf16x8 At[4][2], B0[2][2], B1[2][2];
    const char* cA = (const char*)g.A + (size_t)cur.pm * tstep; const char* cB = (const char*)g.Bt + (size_t)cur.pn * tstep;
    PG8_STAGE(PG8_SB(0, 0), cB, voffA); PG8_STAGE(PG8_SB(0, 1), cB + hstep, voffA); PG8_STAGE(PG8_SA(0, 0), cA, voffA); PG8_STAGE(PG8_SA(0, 1), cA + hstep, voffA);
    if (wr == 1) PG8_BAR;
    PG8_WAIT_V(2); PG8_BAR;
    PG8_STAGE(PG8_SB(1, 0), cB + kstep, voffA); PG8_STAGE(PG8_SA(1, 0), cA + kstep, voffA); PG8_STAGE(PG8_SB(1, 1), cB + hstep + kstep, voffA);
    PG8_WAIT_V(6); PG8_BAR;
    for (;;) {
        const bool has_next = S.next(ui + 1, nxt);
        const char* nA = has_next ? (const char*)g.A + (size_t)nxt.pm * tstep : cA; const char* nB = has_next ? (const char*)g.Bt + (size_t)nxt.pn * tstep : cB;
        for (int t = 0; t < nt; t += 2) {
            const bool last = (t == nt - 2);
            const char* a1 = cA + (size_t)(t + 1) * kstep;
            const char* a2 = last ? nA : cA + (size_t)(t + 2) * kstep; const char* b2 = last ? nB : cB + (size_t)(t + 2) * kstep;
            const char* a3 = a2 + kstep; const char* b3 = b2 + kstep;
            PG8_LDB(B0, 0, 0); PG8_LDB(B1, 0, 1); PG8_SCHED; PG8_LDA(At, 0, 0); PG8_STAGE(PG8_SA(1, 1), a1 + hstep, voffA);
            PG8_WAIT_V(8); PG8_WAIT_L(0); PG8_BAR; PG8_MMA(0, 0, At, B0); PG8_MMA(0, 1, At, B1); PG8_BAR; PG8_SCHED;
            PG8_LDA(At, 0, 1); PG8_STAGE(PG8_SB(0, 0), b2, voffA); PG8_STAGE(PG8_SB(0, 1), b2 + hstep, voffA); PG8_STAGE(PG8_SA(0, 0), a2, voffA);
            PG8_WAIT_V(8); PG8_WAIT_L(0); PG8_BAR; PG8_MMA(1, 0, At, B0); PG8_MMA(1, 1, At, B1); PG8_BAR; PG8_SCHED;
            PG8_LDB(B0, 1, 0); PG8_LDB(B1, 1, 1); PG8_SCHED; PG8_LDA(At, 1, 0); PG8_STAGE(PG8_SA(0, 1), a2 + hstep, voffA);
            PG8_WAIT_V(8); PG8_WAIT_L(0); PG8_BAR; PG8_MMA(0, 0, At, B0); PG8_MMA(0, 1, At, B1); PG8_BAR; PG8_SCHED;
            PG8_LDA(At, 1, 1); PG8_STAGE(PG8_SB(1, 0), b3, voffA); PG8_STAGE(PG8_SB(1, 1), b3 + hstep, voffA); PG8_STAGE(PG8_SA(1, 0), a3, voffA);
            PG8_WAIT_V(8); PG8_WAIT_L(0); PG8_BAR; PG8_MMA(1, 0, At, B0); PG8_MMA(1, 1, At, B1); PG8_BAR; PG8_SCHED;
        }
        if (wr == 0) PG8_BAR;
        { int t2_ = threadIdx.x; asm volatile("" : "+v"(t2_));
          E(acc, cur, wr, wc, t2_ & 15, (t2_ & 63) >> 4); }
        if (!has_next) break;
#pragma unroll
        for (int a = 0; a < 2; ++a)
#pragma unroll
            for (int b = 0; b < 2; ++b)
#pragma unroll
                for (int m = 0; m < 4; ++m)
#pragma unroll
                    for (int n = 0; n < 2; ++n) acc[a][b][m][n] = (f32x4){0.f, 0.f, 0.f, 0.f};
        cur = nxt; cA = nA; cB = nB; ++ui;
        if (wr == 1) PG8_BAR;
    }
    PG8_WAIT_V(0);
    PG8_BAR;
#undef PG8_SA
#undef PG8_SB
#undef PG8_STAGE
#undef PG8_LDA
#undef PG8_LDB
#undef PG8_MMA
#undef PG8_WAIT_V
#undef PG8_WAIT_L
#undef PG8_BAR
#undef PG8_SCHED
}
}

__host__ __device__ __forceinline__ int pmap256(int c) { return 128 * ((c >> 5) & 1) + 32 * (c >> 6) + 16 * ((c >> 2) & 1) + 4 * ((c >> 3) & 3) + (c & 3); }
__host__ __device__ __forceinline__ int pmap128(int c) { return 32 * (c >> 5) + 16 * ((c >> 2) & 1) + 4 * ((c >> 3) & 3) + (c & 3); }

#define EPI_BAR() do { asm volatile("s_waitcnt lgkmcnt(0)" ::: "memory"); __builtin_amdgcn_s_barrier(); asm volatile("" ::: "memory"); } while (0)

struct EpiProj {
    bf16_t *QD, *KD, *VD, *CQ, *CKV; float *SSQ_Q, *SSQ_KV, *SSQ_PE, *KR; const float *gq, *gk, *gkm, *ropeC, *ropeS;
    __device__ __forceinline__ void operator()(pg8::Acc& acc, const pg8::Unit& u, int wr, int wc, int fr, int fq) const {
        const int g = u.pn * 4 + wc, rowb = u.pm * 256 + wr * 64 + fr, cl = 8 * fq;
        if (g < 32) {
            const float* gv = g < 16 ? gq : gk; const float sc = g < 16 ? QD_SCALE : 1.f;
            f32x4 gg[2][2];
#pragma unroll
            for (int bj = 0; bj < 2; ++bj)
#pragma unroll
                for (int n = 0; n < 2; ++n) gg[bj][n] = *(const f32x4*)(gv + 32 * bj + cl + 4 * n) * sc;
            bf16_t* dst = QD + (g & 15) * 64 + cl; unsigned char* dst8 = (unsigned char*)KD + (g & 15) * 64 + cl;
#pragma unroll
            for (int ai = 0; ai < 2; ++ai)
#pragma unroll
                for (int m = 0; m < 4; ++m) {
                    const size_t row = (size_t)(rowb + 128 * ai + 16 * m);
                    float ss = 0.f;
#pragma unroll
                    for (int bj = 0; bj < 2; ++bj)
#pragma unroll
                        for (int n = 0; n < 2; ++n) { const f32x4 x = acc[ai][bj][m][n]; ss += (x[0] * x[0] + x[1] * x[1]) + (x[2] * x[2] + x[3] * x[3]); }
                    ss += __shfl_xor(ss, 16); ss += __shfl_xor(ss, 32);
                    const float rs = rsq(ss * (1.f / 64.f) + EPS);
#pragma unroll
                    for (int bj = 0; bj < 2; ++bj) { const f32x4 v0 = acc[ai][bj][m][0] * rs * gg[bj][0], v1 = acc[ai][bj][m][1] * rs * gg[bj][1];
                        if (g < 16) { u32x4 w; w.x = cvt_pk_bf16(v0[0], v0[1]); w.y = cvt_pk_bf16(v0[2], v0[3]); w.z = cvt_pk_bf16(v1[0], v1[1]); w.w = cvt_pk_bf16(v1[2], v1[3]);
                            *(u32x4*)(dst + row * 1024 + 32 * bj) = w; }
                        else { u32x2 w8; w8.x = (unsigned)pk4_fp8(v0[0], v0[1], v0[2], v0[3]); w8.y = (unsigned)pk4_fp8(v1[0], v1[1], v1[2], v1[3]); *(u32x2*)(dst8 + row * 1024 + 32 * bj) = w8; } }
                }
        } else if (g < 60) {
            bf16_t* dst; int ld; float* ssp = nullptr; int sw = 0, si = 0;
            const bool v8 = g < 48;
            if (g < 48) { dst = VD; ld = 0; }
            else if (g < 56) { dst = CQ + (g - 48) * 64 + cl; ld = 512; ssp = SSQ_Q; sw = 8; si = g - 48; }
            else { dst = CKV + (g - 56) * 64 + cl; ld = 256; ssp = SSQ_KV; sw = 4; si = g - 56; }
#pragma unroll
            for (int ai = 0; ai < 2; ++ai)
#pragma unroll
                for (int m = 0; m < 4; ++m) {
                    const size_t row = (size_t)(rowb + 128 * ai + 16 * m);
                    float ss = 0.f;
#pragma unroll
                    for (int bj = 0; bj < 2; ++bj) { const f32x4 v0 = acc[ai][bj][m][0], v1 = acc[ai][bj][m][1];
                        ss += (v0[0] * v0[0] + v0[1] * v0[1]) + (v0[2] * v0[2] + v0[3] * v0[3]) + (v1[0] * v1[0] + v1[1] * v1[1]) + (v1[2] * v1[2] + v1[3] * v1[3]);
                        if (v8) { u32x2 w8; w8.x = (unsigned)pk4_fp8(v0[0], v0[1], v0[2], v0[3]); w8.y = (unsigned)pk4_fp8(v1[0], v1[1], v1[2], v1[3]);
                            const int tok_ = (int)row & (SEQ - 1), k5_ = tok_ & 31, p_ = 32 * ((k5_ >> 2) & 1) + 16 * ((tok_ >> 5) & 1) + (k5_ & 3) + 4 * (k5_ >> 3);
                            unsigned char* dp_ = (unsigned char*)VD + ((size_t)(((int)row >> 12) * 8 + ((g - 32) >> 1)) * 128 + ((g - 32) & 1) * 64 + cl + 32 * bj) * SEQ + (tok_ & ~63) + p_;
                            dp_[0] = (unsigned char)(w8.x); dp_[SEQ] = (unsigned char)(w8.x >> 8); dp_[2 * SEQ] = (unsigned char)(w8.x >> 16); dp_[3 * SEQ] = (unsigned char)(w8.x >> 24);
                            dp_[4 * SEQ] = (unsigned char)(w8.y); dp_[5 * SEQ] = (unsigned char)(w8.y >> 8); dp_[6 * SEQ] = (unsigned char)(w8.y >> 16); dp_[7 * SEQ] = (unsigned char)(w8.y >> 24); }
                        else { u32x4 w; w.x = cvt_pk_bf16(v0[0], v0[1]); w.y = cvt_pk_bf16(v0[2], v0[3]); w.z = cvt_pk_bf16(v1[0], v1[1]); w.w = cvt_pk_bf16(v1[2], v1[3]);
                            *(u32x4*)(dst + row * ld + 32 * bj) = w; } }
                    if (ssp) { ss += __shfl_xor(ss, 16); ss += __shfl_xor(ss, 32); if (fq == 0) ssp[row * sw + si] = ss; }
                }
        } else if (g == 60) {
            f32x4 g1[2], g2[2];
#pragma unroll
            for (int n = 0; n < 2; ++n) { g1[n] = *(const f32x4*)(gkm + 128 + cl + 4 * n); g2[n] = *(const f32x4*)(gkm + 160 + cl + 4 * n); }
#pragma unroll
            for (int ai = 0; ai < 2; ++ai)
#pragma unroll
                for (int m = 0; m < 4; ++m) {
                    const size_t row = (size_t)(rowb + 128 * ai + 16 * m); const int pos = (int)(row & (SEQ - 1));
                    float ss = 0.f;
#pragma unroll
                    for (int n = 0; n < 2; ++n) { const f32x4 x1 = acc[ai][0][m][n], x2 = acc[ai][1][m][n];
                        ss += (x1[0] * x1[0] + x1[1] * x1[1]) + (x1[2] * x1[2] + x1[3] * x1[3]) + (x2[0] * x2[0] + x2[1] * x2[1]) + (x2[2] * x2[2] + x2[3] * x2[3]);
                        const f32x4 c = *(const f32x4*)(ropeC + pos * 32 + cl + 4 * n), s = *(const f32x4*)(ropeS + pos * 32 + cl + 4 * n);
                        const f32x4 a = x1 * g1[n], b = x2 * g2[n];
                        *(f32x4*)(KR + row * 64 + cl + 4 * n) = a * c - b * s;
                        *(f32x4*)(KR + row * 64 + 32 + cl + 4 * n) = b * c + a * s; }
                    ss += __shfl_xor(ss, 16); ss += __shfl_xor(ss, 32); if (fq == 0) SSQ_PE[row] = ss;
                }
        }
    }
};

struct EpiQ {
    bf16_t* QM; const float *SSQ_Q, *gqm, *ropeC, *ropeS; LAS float* P;
    __device__ __forceinline__ void operator()(pg8::Acc& acc, const pg8::Unit& u, int wr, int wc, int fr, int fq) const {
        const int h = u.pn, rowb = u.pm * 256 + wr * 64 + fr, cl = 8 * fq;
#pragma unroll
        for (int ai = 0; ai < 2; ++ai)
#pragma unroll
            for (int m = 0; m < 4; ++m) {
                const size_t row = (size_t)(rowb + 128 * ai + 16 * m);
                const f32x4 s0 = *(const f32x4*)(SSQ_Q + row * 8), s1 = *(const f32x4*)(SSQ_Q + row * 8 + 4);
                const float ra = rsq(((s0[0] + s0[1]) + (s0[2] + s0[3]) + (s1[0] + s1[1]) + (s1[2] + s1[3])) * (1.f / 512.f) + EPS);
                float ss = 0.f;
#pragma unroll
                for (int bj = 0; bj < 2; ++bj)
#pragma unroll
                    for (int n = 0; n < 2; ++n) { const f32x4 x = acc[ai][bj][m][n] * ra; acc[ai][bj][m][n] = x; ss += (x[0] * x[0] + x[1] * x[1]) + (x[2] * x[2] + x[3] * x[3]); }
                ss += __shfl_xor(ss, 16); ss += __shfl_xor(ss, 32);
                if (fq == 0) P[(128 * ai + 64 * wr + 16 * m + fr) * 4 + wc] = ss;
            }
        EPI_BAR();
        if (wc < 3) {
            f32x4 gg[2][2];
#pragma unroll
            for (int bj = 0; bj < 2; ++bj)
#pragma unroll
                for (int n = 0; n < 2; ++n) gg[bj][n] = *(const f32x4*)(gqm + 64 * wc + 32 * bj + cl + 4 * n) * QM_SCALE;
#pragma unroll
            for (int ai = 0; ai < 2; ++ai)
#pragma unroll
                for (int m = 0; m < 4; ++m) {
                    const size_t row = (size_t)(rowb + 128 * ai + 16 * m);
                    const f32x4 pp = *(const LAS f32x4*)(P + (128 * ai + 64 * wr + 16 * m + fr) * 4);
                    const float rs = rsq((pp[0] + pp[1] + pp[2]) * (1.f / 192.f) + EPS);
                    bf16_t* dst = QM + row * 1536 + h * 192 + 64 * wc + cl;
                    f32x4 v[2][2];
#pragma unroll
                    for (int bj = 0; bj < 2; ++bj)
#pragma unroll
                        for (int n = 0; n < 2; ++n) v[bj][n] = acc[ai][bj][m][n] * rs * gg[bj][n];
#pragma unroll
                    for (int bj = 0; bj < 2; ++bj) { u32x4 w; w.x = cvt_pk_bf16_ord(v[bj][0][0], v[bj][0][1]); w.y = cvt_pk_bf16_ord(v[bj][0][2], v[bj][0][3]); w.z = cvt_pk_bf16_ord(v[bj][1][0], v[bj][1][1]); w.w = cvt_pk_bf16_ord(v[bj][1][2], v[bj][1][3]);
                        *(u32x4*)(dst + 32 * bj) = w; }
                }
        }
    }
};

struct EpiKV {
    unsigned char *K8, *V8; const float *SSQ_KV, *SSQ_PE, *KR, *gkm; LAS float* P;
    __device__ __forceinline__ void operator()(pg8::Acc& acc, const pg8::Unit& u, int wr, int wc, int fr, int fq) const {
        const int h = u.pn, rowb = u.pm * 256 + wr * 64 + fr, cl = 8 * fq;
#pragma unroll
        for (int ai = 0; ai < 2; ++ai)
#pragma unroll
            for (int m = 0; m < 4; ++m) {
                const size_t row = (size_t)(rowb + 128 * ai + 16 * m);
                const f32x4 s0 = *(const f32x4*)(SSQ_KV + row * 4);
                const float ra = rsq(((s0[0] + s0[1]) + (s0[2] + s0[3])) * (1.f / 256.f) + EPS);
                float ss = 0.f;
#pragma unroll
                for (int bj = 0; bj < 2; ++bj)
#pragma unroll
                    for (int n = 0; n < 2; ++n) { const f32x4 x = acc[ai][bj][m][n] * ra; acc[ai][bj][m][n] = x; ss += (x[0] * x[0] + x[1] * x[1]) + (x[2] * x[2] + x[3] * x[3]); }
                if (wc < 2) { ss += __shfl_xor(ss, 16); ss += __shfl_xor(ss, 32); if (fq == 0) P[(128 * ai + 64 * wr + 16 * m + fr) * 4 + wc] = ss; }
                else {
                    const int tok_ = (int)row & (SEQ - 1), k5_ = tok_ & 31, p_ = 32 * ((k5_ >> 2) & 1) + 16 * ((tok_ >> 5) & 1) + (k5_ & 3) + 4 * (k5_ >> 3);
                    unsigned char* dp_ = V8 + ((size_t)(((int)row >> 12) * 8 + h) * 128 + 64 * (wc - 2) + cl) * SEQ + (tok_ & ~63) + p_;
#pragma unroll
                    for (int bj = 0; bj < 2; ++bj) { const f32x4 v0 = acc[ai][bj][m][0], v1 = acc[ai][bj][m][1];
                        const unsigned w0 = (unsigned)pk4_fp8(v0[0], v0[1], v0[2], v0[3]), w1 = (unsigned)pk4_fp8(v1[0], v1[1], v1[2], v1[3]); unsigned char* q_ = dp_ + (size_t)(32 * bj) * SEQ;
                        q_[0] = (unsigned char)w0; q_[SEQ] = (unsigned char)(w0 >> 8); q_[2 * SEQ] = (unsigned char)(w0 >> 16); q_[3 * SEQ] = (unsigned char)(w0 >> 24);
                        q_[4 * SEQ] = (unsigned char)w1; q_[5 * SEQ] = (unsigned char)(w1 >> 8); q_[6 * SEQ] = (unsigned char)(w1 >> 16); q_[7 * SEQ] = (unsigned char)(w1 >> 24); } }
            }
        EPI_BAR();
        if (wc < 2) {
            f32x4 gg[2][2];
#pragma unroll
            for (int bj = 0; bj < 2; ++bj)
#pragma unroll
                for (int n = 0; n < 2; ++n) gg[bj][n] = *(const f32x4*)(gkm + 64 * wc + 32 * bj + cl + 4 * n);
#pragma unroll
            for (int ai = 0; ai < 2; ++ai)
#pragma unroll
                for (int m = 0; m < 4; ++m) {
                    const size_t row = (size_t)(rowb + 128 * ai + 16 * m);
                    const f32x2 pp = *(const LAS f32x2*)(P + (128 * ai + 64 * wr + 16 * m + fr) * 4);
                    const float rs = rsq((pp[0] + pp[1] + SSQ_PE[row]) * (1.f / 192.f) + EPS);
                    unsigned char* dst = K8 + row * 1536 + h * 192 + 64 * wc + cl;
#pragma unroll
                    for (int bj = 0; bj < 2; ++bj) { const f32x4 v0 = acc[ai][bj][m][0] * rs * gg[bj][0], v1 = acc[ai][bj][m][1] * rs * gg[bj][1];
                        u32x2 w; w.x = (unsigned)pk4_fp8(v0[0], v0[1], v0[2], v0[3]); w.y = (unsigned)pk4_fp8(v1[0], v1[1], v1[2], v1[3]);
                        *(u32x2*)(dst + 32 * bj) = w; }
                }
        } else {
            const int co = 32 * (wc - 2) + cl;
            f32x4 ka[2][4], kb2[2][4];
#pragma unroll
            for (int ai = 0; ai < 2; ++ai)
#pragma unroll
                for (int m = 0; m < 4; ++m) { const size_t row = (size_t)(rowb + 128 * ai + 16 * m); ka[ai][m] = *(const f32x4*)(KR + row * 64 + co); kb2[ai][m] = *(const f32x4*)(KR + row * 64 + co + 4); }
#pragma unroll
            for (int ai = 0; ai < 2; ++ai)
#pragma unroll
                for (int m = 0; m < 4; ++m) {
                    const size_t row = (size_t)(rowb + 128 * ai + 16 * m);
                    const f32x2 pp = *(const LAS f32x2*)(P + (128 * ai + 64 * wr + 16 * m + fr) * 4);
                    const float rs = rsq((pp[0] + pp[1] + SSQ_PE[row]) * (1.f / 192.f) + EPS);
                    const f32x4 a = ka[ai][m] * rs, b = kb2[ai][m] * rs;
                    u32x2 w; w.x = (unsigned)pk4_fp8(a[0], a[1], a[2], a[3]); w.y = (unsigned)pk4_fp8(b[0], b[1], b[2], b[3]);
                    *(u32x2*)(K8 + row * 1536 + h * 192 + 128 + co) = w; }
        }
    }
};

__device__ __forceinline__ float bf2f(unsigned short v) { return __uint_as_float((unsigned)v << 16); }
struct EpiRes1 {
    const float* base; const float* gate; bf16_t* out;
    __device__ __forceinline__ void operator()(pg8::Acc& acc, const pg8::Unit& u, int wr, int wc, int fr, int fq) const {
        const int rowb = u.pm * 256 + wr * 64 + fr, col0 = u.pn * 256 + wc * 32 + 8 * fq; const int b = u.pm >> 4;
        f32x4 gt[2][2];
#pragma unroll
        for (int bj = 0; bj < 2; ++bj)
#pragma unroll
            for (int n = 0; n < 2; ++n) gt[bj][n] = *(const f32x4*)(gate + (size_t)b * MODW + col0 + 128 * bj + 4 * n);
#pragma unroll
        for (int ai = 0; ai < 2; ++ai) {
            f32x4 bs[4][2][2];
#pragma unroll
            for (int m = 0; m < 4; ++m) { const size_t off = (size_t)(rowb + 128 * ai + 16 * m) * DM + col0;
#pragma unroll
                for (int bj = 0; bj < 2; ++bj)
#pragma unroll
                    for (int n = 0; n < 2; ++n) bs[m][bj][n] = __builtin_nontemporal_load((const f32x4*)(base + off + 128 * bj + 4 * n)); }
#pragma unroll
            for (int m = 0; m < 4; ++m) { const size_t off = (size_t)(rowb + 128 * ai + 16 * m) * DM + col0;
#pragma unroll
                for (int bj = 0; bj < 2; ++bj) { const f32x4 v0 = bs[m][bj][0] + gt[bj][0] * acc[ai][bj][m][0], v1 = bs[m][bj][1] + gt[bj][1] * acc[ai][bj][m][1];
                    u32x4 w; w.x = cvt_pk_bf16(v0[0], v0[1]); w.y = cvt_pk_bf16(v0[2], v0[3]); w.z = cvt_pk_bf16(v1[0], v1[1]); w.w = cvt_pk_bf16(v1[2], v1[3]);
                    *(u32x4*)(out + off + 128 * bj) = w; } }
        }
    }
};
struct EpiRes2 {
    const bf16_t* base; const float* gate; float* out;
    __device__ __forceinline__ void operator()(pg8::Acc& acc, const pg8::Unit& u, int wr, int wc, int fr, int fq) const {
        const int rowb = u.pm * 256 + wr * 64 + fr, col0 = u.pn * 256 + wc * 32 + 8 * fq; const int b = u.pm >> 4;
        f32x4 gt[2][2];
#pragma unroll
        for (int bj = 0; bj < 2; ++bj)
#pragma unroll
            for (int n = 0; n < 2; ++n) gt[bj][n] = *(const f32x4*)(gate + (size_t)b * MODW + col0 + 128 * bj + 4 * n);
#pragma unroll
        for (int ai = 0; ai < 2; ++ai) {
            bf16x8 bs[4][2];
#pragma unroll
            for (int m = 0; m < 4; ++m) { const size_t off = (size_t)(rowb + 128 * ai + 16 * m) * DM + col0;
#pragma unroll
                for (int bj = 0; bj < 2; ++bj) bs[m][bj] = *(const bf16x8*)(base + off + 128 * bj); }
#pragma unroll
            for (int m = 0; m < 4; ++m) { const size_t off = (size_t)(rowb + 128 * ai + 16 * m) * DM + col0;
#pragma unroll
                for (int bj = 0; bj < 2; ++bj) { const bf16x8 r = bs[m][bj];
                    const f32x4 x0 = {bf2f((unsigned short)r[0]), bf2f((unsigned short)r[1]), bf2f((unsigned short)r[2]), bf2f((unsigned short)r[3])};
                    const f32x4 x1 = {bf2f((unsigned short)r[4]), bf2f((unsigned short)r[5]), bf2f((unsigned short)r[6]), bf2f((unsigned short)r[7])};
                    *(f32x4*)(out + off + 128 * bj) = x0 + gt[bj][0] * acc[ai][bj][m][0];
                    *(f32x4*)(out + off + 128 * bj + 4) = x1 + gt[bj][1] * acc[ai][bj][m][1]; } }
        }
    }
};

struct EpiSwiglu {
    bf16_t* H;
    __device__ __forceinline__ void operator()(pg8::Acc& acc, const pg8::Unit& u, int wr, int wc, int fr, int fq) const {
        const int rowb = u.pm * 256 + wr * 64 + fr, col0 = u.pn * 128 + wc * 32 + 8 * fq;
#pragma unroll
        for (int ai = 0; ai < 2; ++ai)
#pragma unroll
            for (int m = 0; m < 4; ++m) { bf16_t* dst = H + (size_t)(rowb + 128 * ai + 16 * m) * DFF + col0;
                f32x4 hv[2];
#pragma unroll
                for (int n = 0; n < 2; ++n) { const f32x4 gv = acc[ai][0][m][n], uv = acc[ai][1][m][n];
#pragma unroll
                    for (int j = 0; j < 4; ++j) hv[n][j] = gv[j] * __builtin_amdgcn_rcpf(1.f + ex2(-gv[j] * LOG2E)) * uv[j]; }
                u32x4 w; w.x = cvt_pk_bf16(hv[0][0], hv[0][1]); w.y = cvt_pk_bf16(hv[0][2], hv[0][3]); w.z = cvt_pk_bf16(hv[1][0], hv[1][1]); w.w = cvt_pk_bf16(hv[1][2], hv[1][3]);
                *(u32x4*)dst = w; }
    }
};

namespace att {
#define SBAR() __builtin_amdgcn_sched_barrier(0)
template <int OFF> __device__ __forceinline__ s16x4 tr_read(int vb) { s16x4 r; asm volatile("ds_read_b64_tr_b16 %0, %1 offset:%2" : "=&v"(r) : "v"(vb), "i"(OFF) : "memory"); return r; }
struct Tensors { const bf16_t *Q, *K, *V; bf16_t* MIX; const float *ropeC, *ropeS; };
constexpr int OFF_V = 0, OFF_K = 32768, OFF_WS = 81920, OFF_TBL = 83968, OFF_STG = 86016, OFF_QR = 86016, OFF_XCH = 0;
typedef int i32x8 __attribute__((ext_vector_type(8)));
typedef int i32x4 __attribute__((ext_vector_type(4)));
struct Tensors8 { const bf16_t* Q; const unsigned char* K8; const unsigned char* VT8; bf16_t* MIX; const float *ropeC, *ropeS; };
__device__ __forceinline__ int crow32(int r, int hi) { return (r & 3) + 8 * (r >> 2) + 4 * hi; }
__device__ __forceinline__ f32x16 mfma8(i32x8 a, i32x8 b, f32x16 c) { return __builtin_amdgcn_mfma_scale_f32_32x32x64_f8f6f4(a, b, c, 0, 0, 0, 0, 0, 0); }
typedef short s16x2 __attribute__((ext_vector_type(2)));
__device__ __forceinline__ int pk4_fp8s(int prev, float a, float b, float c, float d) { s16x2 r = __builtin_bit_cast(s16x2, prev);     r = __builtin_amdgcn_cvt_scalef32_pk_fp8_f32(r, a, b, 64.0f, false); r = __builtin_amdgcn_cvt_scalef32_pk_fp8_f32(r, c, d, 64.0f, true); return __builtin_bit_cast(int, r); }
constexpr int M8_OFF_V = 0, M8_VT = 8192, M8_OFF_K = 16384, M8_KT = 12288, M8_OFF_WS = 81920;

__device__ __forceinline__ void attn_unit_mla8(const Tensors8& T, int b, int h, int qblk, LAS char* lds) {
    constexpr int NT = SEQ / 64;
    int tid = threadIdx.x; asm volatile("" : "+v"(tid));
    const int wid = __builtin_amdgcn_readfirstlane(tid >> 6), lane = tid & 63, r32 = lane & 31, hi = lane >> 5;
    const size_t tok0 = (size_t)b * SEQ; const int qw0 = qblk * 256 + wid * 32;
    LAS char* V_lds = lds + M8_OFF_V; LAS char* K_lds = lds + M8_OFF_K;
    i32x8 q8[3];
    { const bf16_t* Qw = T.Q + (tok0 + qw0 + r32) * 1536 + h * 192;
      float v[32];
#pragma unroll
      for (int s = 0; s < 2; ++s) {
#pragma unroll
          for (int c = 0; c < 4; ++c) { const bf16x8 t = *(const bf16x8*)(Qw + 64 * s + 32 * hi + 8 * c);
#pragma unroll
              for (int e = 0; e < 8; ++e) v[8 * c + e] = bf2f((unsigned short)t[e]); }
#pragma unroll
          for (int w = 0; w < 8; ++w) q8[s][w] = pk4_fp8(v[4 * w], v[4 * w + 1], v[4 * w + 2], v[4 * w + 3]); }
      const int pos = qw0 + r32; const float* cp = T.ropeC + pos * 32; const float* sp = T.ropeS + pos * 32;
#pragma unroll
      for (int c = 0; c < 4; ++c) { const bf16x8 t1 = *(const bf16x8*)(Qw + 128 + 8 * c), t2 = *(const bf16x8*)(Qw + 160 + 8 * c);
          const f32x4 c0 = *(const f32x4*)(cp + 8 * c), c1 = *(const f32x4*)(cp + 8 * c + 4), s0 = *(const f32x4*)(sp + 8 * c), s1 = *(const f32x4*)(sp + 8 * c + 4);
#pragma unroll
          for (int e = 0; e < 8; ++e) { const float x1 = bf2f((unsigned short)t1[e]), x2 = bf2f((unsigned short)t2[e]), cc = e < 4 ? c0[e & 3] : c1[e & 3], ss = e < 4 ? s0[e & 3] : s1[e & 3];
              v[8 * c + e] = hi ? (x2 * cc + x1 * ss) : (x1 * cc - x2 * ss); } }
#pragma unroll
      for (int w = 0; w < 8; ++w) q8[2][w] = pk4_fp8(v[4 * w], v[4 * w + 1], v[4 * w + 2], v[4 * w + 3]);
    }
    const unsigned char* Kp = T.K8 + tok0 * 1536 + h * 192; const unsigned char* Vp = T.VT8 + ((size_t)(b * 8 + h) * 128) * SEQ;
    int ksoff[2]; int vsoff;
#pragma unroll
    for (int i = 0; i < 2; ++i) { const int L = 1024 * (wid + 8 * i) + 16 * lane; const int row = L / 192, pc = (L - 192 * row) >> 4, c = (pc & ~3) | ((pc & 3) ^ ((row >> 2) & 3)); ksoff[i] = row * 1536 + 16 * c; }
    { const int d = 16 * wid + (lane >> 2), c = (lane & 3) ^ ((d >> 2) & 3); vsoff = d * SEQ + 16 * c; }
    const int sw = (r32 >> 2) & 3;
    LAS char* kxa[2]; LAS char* vxa[2];
#pragma unroll
    for (int e = 0; e < 2; ++e) { kxa[e] = K_lds + r32 * 192 + 16 * ((2 * hi + e) ^ sw); vxa[e] = V_lds + r32 * 64 + 16 * ((2 * hi + e) ^ sw); }
#define DMA_K(bf) do { __builtin_amdgcn_global_load_lds((const unsigned*)(Kp + ksoff[0]), (LAS unsigned*)(K_lds + (bf) * M8_KT + wid * 1024), 16, 0, 0); \
        if (wid < 4) __builtin_amdgcn_global_load_lds((const unsigned*)(Kp + ksoff[1]), (LAS unsigned*)(K_lds + (bf) * M8_KT + (wid + 8) * 1024), 16, 0, 0); Kp += 64 * 1536; } while (0)
#define DMA_V(bf) do { __builtin_amdgcn_global_load_lds((const unsigned*)(Vp + vsoff), (LAS unsigned*)(V_lds + (bf) * M8_VT + wid * 1024), 16, 0, 0); Vp += 64; } while (0)
#define TSYNC() do { asm volatile("s_waitcnt vmcnt(0)" ::: "memory"); __syncthreads(); } while (0)
#define KFR(bf, kb, s) ({ i32x8 f_; const i32x4 lo_ = *(const LAS i32x4*)(kxa[0] + (bf) * M8_KT + (kb) * 32 * 192 + (s) * 64), hi_ = *(const LAS i32x4*)(kxa[1] + (bf) * M8_KT + (kb) * 32 * 192 + (s) * 64); \
        f_[0] = lo_[0]; f_[1] = lo_[1]; f_[2] = lo_[2]; f_[3] = lo_[3]; f_[4] = hi_[0]; f_[5] = hi_[1]; f_[6] = hi_[2]; f_[7] = hi_[3]; f_; })
#define VFR(bf, db) ({ i32x8 f_; const i32x4 lo_ = *(const LAS i32x4*)(vxa[0] + (bf) * M8_VT + (db) * 32 * 64), hi_ = *(const LAS i32x4*)(vxa[1] + (bf) * M8_VT + (db) * 32 * 64); \
        f_[0] = lo_[0]; f_[1] = lo_[1]; f_[2] = lo_[2]; f_[3] = lo_[3]; f_[4] = hi_[0]; f_[5] = hi_[1]; f_[6] = hi_[2]; f_[7] = hi_[3]; f_; })
#define QKT(P, bf) do { _Pragma("unroll") for (int s_ = 0; s_ < 3; ++s_) _Pragma("unroll") for (int kb_ = 0; kb_ < 2; ++kb_) { const i32x8 kf_ = KFR(bf, kb_, s_); P[kb_] = mfma8(kf_, q8[s_], s_ == 0 ? (f32x16){} : P[kb_]); } SBAR(); } while (0)
#define PARTIAL(P) do { _Pragma("unroll") for (int r_ = 0; r_ < 16; ++r_) P[0][r_] = ex2(P[0][r_]); } while (0)
    f32x16 o[4] = {}, lacc = {}; f32x16 pA[2], pB[2]; i32x8 p8 = {};
    const i32x8 ones8 = {0x38383838, 0x38383838, 0x38383838, 0x38383838, 0x38383838, 0x38383838, 0x38383838, 0x38383838};
#define FIND(P, bfK, bfV, DOK) do { \
        _Pragma("unroll") for (int r_ = 0; r_ < 8; ++r_) P[1][r_] = ex2(P[1][r_]); SBAR(); if (DOK) DMA_K(bfK); SBAR(); \
        _Pragma("unroll") for (int r_ = 8; r_ < 16; ++r_) P[1][r_] = ex2(P[1][r_]); SBAR(); DMA_V(bfV); SBAR(); \
        _Pragma("unroll") for (int w_ = 0; w_ < 8; ++w_) p8[w_] = pk4_fp8s(p8[w_], P[w_ >> 2][4 * (w_ & 3)], P[w_ >> 2][4 * (w_ & 3) + 1], P[w_ >> 2][4 * (w_ & 3) + 2], P[w_ >> 2][4 * (w_ & 3) + 3]); \
        lacc = mfma8(p8, ones8, lacc); SBAR(); } while (0)
#define FIN0(P) do { _Pragma("unroll") for (int r_ = 0; r_ < 16; ++r_) P[1][r_] = ex2(P[1][r_]); \
        _Pragma("unroll") for (int w_ = 0; w_ < 8; ++w_) p8[w_] = pk4_fp8s(p8[w_], P[w_ >> 2][4 * (w_ & 3)], P[w_ >> 2][4 * (w_ & 3) + 1], P[w_ >> 2][4 * (w_ & 3) + 2], P[w_ >> 2][4 * (w_ & 3) + 3]); \
        lacc = mfma8(p8, ones8, lacc); SBAR(); } while (0)
#define PV(bf) do { _Pragma("unroll") for (int db_ = 0; db_ < 4; ++db_) { const i32x8 vf_ = VFR(bf, db_); o[db_] = mfma8(p8, vf_, o[db_]); } } while (0)
#define PIN_O() do { _Pragma("unroll") for (int d_ = 0; d_ < 4; ++d_) asm volatile("" : "+v"(o[d_])); } while (0)
    DMA_K(0); TSYNC();
    DMA_K(1); DMA_V(0); QKT(pA, 0); PARTIAL(pA); TSYNC();
#define PIN1(x) asm volatile("" : "+v"(x))
#define MF(Pn, kb_, s_, bf) do { const i32x8 kf_ = KFR(bf, kb_, s_); Pn[kb_] = mfma8(kf_, q8[s_], (s_) == 0 ? (f32x16){} : Pn[kb_]); PIN1(Pn[kb_]); } while (0)
#define EX(P, h_, r_) do { float t_ = P[h_][r_]; PIN1(t_); t_ = ex2(t_); PIN1(t_); P[h_][r_] = t_; } while (0)
#define CV(P, w_) do { p8[w_] = pk4_fp8s(p8[w_], P[(w_) >> 2][4 * ((w_) & 3)], P[(w_) >> 2][4 * ((w_) & 3) + 1], P[(w_) >> 2][4 * ((w_) & 3) + 2], P[(w_) >> 2][4 * ((w_) & 3) + 3]); PIN1(p8[w_]); } while (0)
#define HALF(Pn, Pc, bfn, bfc, bfKd, bfVd, DOK) do { \
        if (DOK) DMA_K(bfKd); DMA_V(bfVd); SBAR(); \
        MF(Pn, 0, 0, bfn); EX(Pc, 1, 0); EX(Pc, 1, 1); EX(Pc, 1, 2); CV(Pc, 0); \
        MF(Pn, 1, 0, bfn); EX(Pc, 1, 3); EX(Pc, 1, 4); EX(Pc, 1, 5); CV(Pc, 1); \
        MF(Pn, 0, 1, bfn); EX(Pc, 1, 6); EX(Pc, 1, 7); EX(Pc, 1, 8); CV(Pc, 2); \
        MF(Pn, 1, 1, bfn); EX(Pc, 1, 9); EX(Pc, 1, 10); EX(Pc, 1, 11); CV(Pc, 3); \
        MF(Pn, 0, 2, bfn); EX(Pc, 1, 12); EX(Pc, 1, 13); CV(Pc, 4); CV(Pc, 5); \
        MF(Pn, 1, 2, bfn); EX(Pc, 1, 14); EX(Pc, 1, 15); CV(Pc, 6); CV(Pc, 7); \
        lacc = mfma8(p8, ones8, lacc); PIN1(lacc); EX(Pn, 0, 0); EX(Pn, 0, 1); EX(Pn, 0, 2); \
        { const i32x8 vf_ = VFR(bfc, 0); o[0] = mfma8(p8, vf_, o[0]); PIN1(o[0]); } EX(Pn, 0, 3); EX(Pn, 0, 4); EX(Pn, 0, 5); \
        { const i32x8 vf_ = VFR(bfc, 1); o[1] = mfma8(p8, vf_, o[1]); PIN1(o[1]); } EX(Pn, 0, 6); EX(Pn, 0, 7); EX(Pn, 0, 8); \
        { const i32x8 vf_ = VFR(bfc, 2); o[2] = mfma8(p8, vf_, o[2]); PIN1(o[2]); } EX(Pn, 0, 9); EX(Pn, 0, 10); EX(Pn, 0, 11); \
        { const i32x8 vf_ = VFR(bfc, 3); o[3] = mfma8(p8, vf_, o[3]); PIN1(o[3]); } EX(Pn, 0, 12); EX(Pn, 0, 13); EX(Pn, 0, 14); EX(Pn, 0, 15); \
        TSYNC(); } while (0)
    for (int j = 1; j + 1 < NT; j += 2) {
        HALF(pB, pA, 1, 0, 0, 1, true);
        HALF(pA, pB, 0, 1, 1, 0, true);
    }
    HALF(pB, pA, 1, 0, 0, 1, false);
    FIN0(pB);
    PV(1);
#undef HALF
#undef CV
#undef EX
#undef MF
#undef PIN1
#undef DMA_K
#undef DMA_V
#undef TSYNC
#undef KFR
#undef VFR
#undef QKT
#undef PARTIAL
#undef FIND
#undef FIN0
#undef PV
#undef PIN_O
    {
        int ln = threadIdx.x & 63; asm volatile("" : "+v"(ln));
        const int e32 = ln & 31, ehi = ln >> 5;
        float rli[16];
#pragma unroll
        for (int r = 0; r < 16; ++r) rli[r] = __builtin_amdgcn_rcpf(lacc[r]);
        __syncthreads();
        LAS bf16_t* stg = (LAS bf16_t*)(lds + wid * 8704);
#pragma unroll
        for (int r = 0; r < 16; ++r) { const int orow = crow32(r, ehi);
#pragma unroll
            for (int d0 = 0; d0 < 4; ++d0) { const unsigned w = cvt_pk_bf16(o[d0][r] * rli[r], 0.f); stg[orow * 136 + d0 * 32 + e32] = (bf16_t)w; } }
        asm volatile("s_waitcnt lgkmcnt(0)" ::: "memory");
        bf16_t* Ow = T.MIX + (tok0 + qw0) * 2048 + 1024 + h * 128;
#pragma unroll
        for (int i = 0; i < 8; ++i) { const int row = i * 4 + (ln >> 4), ch = ln & 15; const u32x4 v = *(const LAS u32x4*)(stg + row * 136 + ch * 8); *(u32x4*)(Ow + (size_t)row * 2048 + ch * 8) = v; }
        __syncthreads();
    }
}
struct TensorsD8 { const bf16_t* Q; const unsigned char* K8; const unsigned char* VT8; bf16_t* MIX; };
constexpr int D8_OFF_V = 0, D8_VT = 8192, D8_OFF_K = 16384, D8_KT = 8192;
__device__ __forceinline__ void attn_unit_diff8(const TensorsD8& T, int b, int h, int qblk, LAS char* lds, float lam, const float* relb, const float* gsub) {
    constexpr int NT = SEQ / 64;
    int tid = threadIdx.x; asm volatile("" : "+v"(tid));
    const int wid = __builtin_amdgcn_readfirstlane(tid >> 6), lane = tid & 63, r32 = lane & 31, hi = lane >> 5;
    const int rg = wid & 3, comp = wid >> 2;
    const size_t tok0 = (size_t)b * SEQ; const int qw0 = qblk * 128 + rg * 32;
    LAS char* V_lds = lds + D8_OFF_V; LAS char* K_lds = lds + D8_OFF_K;
    LAS float* tbl = (LAS float*)(lds + OFF_TBL);
    i32x8 q8;
    { const bf16_t* Qw = T.Q + (tok0 + qw0 + r32) * 1024 + h * 128 + comp * 64 + 32 * hi; float v[32];
#pragma unroll
      for (int c = 0; c < 4; ++c) { const bf16x8 t = *(const bf16x8*)(Qw + 8 * c);
#pragma unroll
          for (int e = 0; e < 8; ++e) v[8 * c + e] = bf2f((unsigned short)t[e]); }
#pragma unroll
      for (int w = 0; w < 8; ++w) q8[w] = pk4_fp8(v[4 * w], v[4 * w + 1], v[4 * w + 2], v[4 * w + 3]);
    }
    const unsigned char* Kp = T.K8 + tok0 * 1024 + h * 128; const unsigned char* Vp = T.VT8 + ((size_t)(b * 8 + h) * 128) * SEQ;
    int ksoff, vsoff;
    { const int row = 8 * wid + (lane >> 3), c = (lane & 7) ^ ((row >> 1) & 7); ksoff = row * 1024 + 16 * c; }
    { const int d = 16 * wid + (lane >> 2), c = (lane & 3) ^ ((d >> 2) & 3); vsoff = d * SEQ + 16 * c; }
    LAS char* kxa[2]; LAS char* vxa[2];
#pragma unroll
    for (int e = 0; e < 2; ++e) { kxa[e] = K_lds + r32 * 128 + 16 * ((4 * comp + 2 * hi + e) ^ ((r32 >> 1) & 7)); vxa[e] = V_lds + r32 * 64 + 16 * ((2 * hi + e) ^ ((r32 >> 2) & 3)); }
#define DMA_K(bf) do { __builtin_amdgcn_global_load_lds((const unsigned*)(Kp + ksoff), (LAS unsigned*)(K_lds + (bf) * D8_KT + wid * 1024), 16, 0, 0); Kp += 64 * 1024; } while (0)
#define DMA_V(bf) do { __builtin_amdgcn_global_load_lds((const unsigned*)(Vp + vsoff), (LAS unsigned*)(V_lds + (bf) * D8_VT + wid * 1024), 16, 0, 0); Vp += 64; } while (0)
#define TSYNC() do { asm volatile("s_waitcnt vmcnt(0)" ::: "memory"); __syncthreads(); } while (0)
#define KFR(bf, kb) ({ i32x8 f_; const i32x4 lo_ = *(const LAS i32x4*)(kxa[0] + (bf) * D8_KT + (kb) * 32 * 128), hi_ = *(const LAS i32x4*)(kxa[1] + (bf) * D8_KT + (kb) * 32 * 128); \
        f_[0] = lo_[0]; f_[1] = lo_[1]; f_[2] = lo_[2]; f_[3] = lo_[3]; f_[4] = hi_[0]; f_[5] = hi_[1]; f_[6] = hi_[2]; f_[7] = hi_[3]; f_; })
#define VFR(bf, db) ({ i32x8 f_; const i32x4 lo_ = *(const LAS i32x4*)(vxa[0] + (bf) * D8_VT + (db) * 32 * 64), hi_ = *(const LAS i32x4*)(vxa[1] + (bf) * D8_VT + (db) * 32 * 64); \
        f_[0] = lo_[0]; f_[1] = lo_[1]; f_[2] = lo_[2]; f_[3] = lo_[3]; f_[4] = hi_[0]; f_[5] = hi_[1]; f_[6] = hi_[2]; f_[7] = hi_[3]; f_; })
    const float blneg = relb[15 * 8 + h] * LOG2E, blpos = relb[31 * 8 + h] * LOG2E; int curcls;
    if (tid < 384) { const int rel = tid - 192, n = rel < 0 ? -rel : rel; int bk;
        if (n < 8) bk = n; else { const int lg = 31 - __builtin_clz((unsigned)(n * n)); bk = 2 + lg; if (bk > 15) bk = 15; }
        if (rel > 0) bk += 16;
        tbl[tid] = relb[bk * 8 + h] * LOG2E; }
#define CLS(j) ((64 * (j) - qw0) <= -154 ? 0 : ((64 * (j) - qw0) >= 122 ? 2 : 1))
#define BLC(c) ((c) == 0 ? blneg : ((c) == 2 ? blpos : 0.f))
    curcls = CLS(0);
    f32x16 o[4] = {}, lacc = {}; f32x16 pA[2], pB[2]; i32x8 p8 = {};
    const i32x8 ones8 = {0x38383838, 0x38383838, 0x38383838, 0x38383838, 0x38383838, 0x38383838, 0x38383838, 0x38383838};
#define PIN1(x) asm volatile("" : "+v"(x))
#define MFK(Pn, kb_, kf_) do { Pn[kb_] = mfma8(kf_, q8, (f32x16){}); PIN1(Pn[kb_]); } while (0)
#define EX(P, h_, r_) do { float t_ = P[h_][r_]; PIN1(t_); t_ = ex2(t_); PIN1(t_); P[h_][r_] = t_; } while (0)
#define CV(P, w_) do { p8[w_] = pk4_fp8s(p8[w_], P[(w_) >> 2][4 * ((w_) & 3)], P[(w_) >> 2][4 * ((w_) & 3) + 1], P[(w_) >> 2][4 * ((w_) & 3) + 2], P[(w_) >> 2][4 * ((w_) & 3) + 3]); PIN1(p8[w_]); } while (0)
#define NEAR(P, j) do { if (CLS(j) == 1) { const LAS float* tp_ = tbl + (64 * (j) - qw0 - r32 + 4 * hi + 192); \
            _Pragma("unroll") for (int kb_ = 0; kb_ < 2; ++kb_) _Pragma("unroll") for (int r_ = 0; r_ < 16; ++r_) P[kb_][r_] += tp_[32 * kb_ + (r_ & 3) + 8 * (r_ >> 2)]; SBAR(); } } while (0)
#define RESC(j) do { const int c_ = CLS(j); if (c_ != curcls) { const float f_ = ex2(BLC(curcls) - BLC(c_)); curcls = c_; lacc *= f_; _Pragma("unroll") for (int d_ = 0; d_ < 4; ++d_) o[d_] *= f_; } } while (0)
#define HALF(Pn, Pc, bfn, bfc, bfKd, bfVd, DOK, jn) do { \
        if (DOK) DMA_K(bfKd); DMA_V(bfVd); SBAR(); \
        i32x8 fa_ = KFR(bfn, 0), fb_ = KFR(bfn, 1); \
        MFK(Pn, 0, fa_); fa_ = VFR(bfc, 0); EX(Pc, 1, 0); EX(Pc, 1, 1); EX(Pc, 1, 2); EX(Pc, 1, 3); CV(Pc, 0); CV(Pc, 1); \
        MFK(Pn, 1, fb_); fb_ = VFR(bfc, 1); EX(Pc, 1, 4); EX(Pc, 1, 5); EX(Pc, 1, 6); EX(Pc, 1, 7); CV(Pc, 2); CV(Pc, 3); \
        EX(Pc, 1, 8); EX(Pc, 1, 9); EX(Pc, 1, 10); EX(Pc, 1, 11); CV(Pc, 4); CV(Pc, 5); CV(Pc, 6); \
        EX(Pc, 1, 12); EX(Pc, 1, 13); EX(Pc, 1, 14); EX(Pc, 1, 15); CV(Pc, 7); \
        NEAR(Pn, jn); \
        lacc = mfma8(p8, ones8, lacc); PIN1(lacc); EX(Pn, 0, 0); EX(Pn, 0, 1); EX(Pn, 0, 2); \
        o[0] = mfma8(p8, fa_, o[0]); PIN1(o[0]); fa_ = VFR(bfc, 2); EX(Pn, 0, 3); EX(Pn, 0, 4); EX(Pn, 0, 5); \
        o[1] = mfma8(p8, fb_, o[1]); PIN1(o[1]); fb_ = VFR(bfc, 3); EX(Pn, 0, 6); EX(Pn, 0, 7); EX(Pn, 0, 8); \
        o[2] = mfma8(p8, fa_, o[2]); PIN1(o[2]); EX(Pn, 0, 9); EX(Pn, 0, 10); EX(Pn, 0, 11); \
        o[3] = mfma8(p8, fb_, o[3]); PIN1(o[3]); EX(Pn, 0, 12); EX(Pn, 0, 13); EX(Pn, 0, 14); EX(Pn, 0, 15); \
        RESC(jn); \
        TSYNC(); } while (0)
    DMA_K(0); TSYNC();
    DMA_K(1); DMA_V(0);
    { const i32x8 fa_ = KFR(0, 0), fb_ = KFR(0, 1); pA[0] = mfma8(fa_, q8, (f32x16){}); pA[1] = mfma8(fb_, q8, (f32x16){}); }
    NEAR(pA, 0);
#pragma unroll
    for (int r = 0; r < 16; ++r) pA[0][r] = ex2(pA[0][r]);
    TSYNC();
    for (int j = 1; j + 1 < NT; j += 2) {
        HALF(pB, pA, 1, 0, 0, 1, true, j);
        HALF(pA, pB, 0, 1, 1, 0, true, j + 1);
    }
    HALF(pB, pA, 1, 0, 0, 1, false, NT - 1);
#pragma unroll
    for (int r = 0; r < 16; ++r) pB[1][r] = ex2(pB[1][r]);
#pragma unroll
    for (int w = 0; w < 8; ++w) p8[w] = pk4_fp8s(p8[w], pB[w >> 2][4 * (w & 3)], pB[w >> 2][4 * (w & 3) + 1], pB[w >> 2][4 * (w & 3) + 2], pB[w >> 2][4 * (w & 3) + 3]);
    lacc = mfma8(p8, ones8, lacc);
#pragma unroll
    for (int db = 0; db < 4; ++db) { const i32x8 vf = VFR(1, db); o[db] = mfma8(p8, vf, o[db]); }
#undef HALF
#undef RESC
#undef NEAR
#undef CV
#undef EX
#undef MFK
#undef PIN1
#undef CLS
#undef BLC
#undef KFR
#undef VFR
#undef DMA_K
#undef DMA_V
#undef TSYNC
    {
        int ln = threadIdx.x & 63; asm volatile("" : "+v"(ln));
        const int e32 = ln & 31, ehi = ln >> 5;
        float rli[16];
#pragma unroll
        for (int r = 0; r < 16; ++r) rli[r] = __builtin_amdgcn_rcpf(lacc[r]);
        __syncthreads();
        LAS float* xch = (LAS float*)(lds + OFF_XCH) + rg * 4096 + ln;
        if (comp == 1) { const float nl = -lam;
#pragma unroll
            for (int d0 = 0; d0 < 4; ++d0)
#pragma unroll
                for (int r = 0; r < 16; ++r) xch[(d0 * 16 + r) * 64] = o[d0][r] * rli[r] * nl; }
        __syncthreads();
        if (comp == 0) {
            float gsv[4];
#pragma unroll
            for (int d0 = 0; d0 < 4; ++d0) gsv[d0] = gsub[d0 * 32 + e32] * 0.8f;
            LAS bf16_t* stg = (LAS bf16_t*)(lds + OFF_STG + rg * 8704);
#pragma unroll
            for (int r = 0; r < 16; ++r) { float v[4]; float ss = 0.f;
#pragma unroll
                for (int d0 = 0; d0 < 4; ++d0) { v[d0] = o[d0][r] * rli[r] + xch[(d0 * 16 + r) * 64]; ss += v[d0] * v[d0]; }
                ss += __shfl_xor(ss, 1); ss += __shfl_xor(ss, 2); ss += __shfl_xor(ss, 4); ss += __shfl_xor(ss, 8); ss += __shfl_xor(ss, 16);
                const float rs = rsq(ss * (1.f / 128.f) + EPS); const int orow = crow32(r, ehi);
#pragma unroll
                for (int d0 = 0; d0 < 4; ++d0) { const unsigned w = cvt_pk_bf16(v[d0] * rs * gsv[d0], 0.f); stg[orow * 136 + d0 * 32 + e32] = (bf16_t)w; } }
            asm volatile("s_waitcnt lgkmcnt(0)" ::: "memory");
            bf16_t* Ow = T.MIX + (tok0 + qw0) * 2048 + h * 128;
#pragma unroll
            for (int i = 0; i < 8; ++i) { const int row = i * 4 + (ln >> 4), ch = ln & 15; const u32x4 v = *(const LAS u32x4*)(stg + row * 136 + ch * 8); *(u32x4*)(Ow + (size_t)row * 2048 + ch * 8) = v; }
        }
        __syncthreads();
    }
}
#undef SBAR
}

constexpr int NWAVES = 8, NPH = 9;
constexpr size_t MiB = 1u << 20;
constexpr size_t WS_CTL = 0, CTL_ZERO_BYTES = 1 * MiB, WS_MOD = 512 * 1024;
constexpr size_t WS_ROPEC = 1 * MiB, WS_ROPES = 1 * MiB + 512 * 1024;
constexpr size_t WS_SSQ_Q = 2 * MiB, WS_SSQ_KV = 2 * MiB + 512 * 1024, WS_SSQ_PE = 2 * MiB + 768 * 1024;
constexpr size_t WS_KR = 3 * MiB;
constexpr size_t WS_WIN = 8 * MiB, WS_WQB = 24 * MiB, WS_WKVB = 26 * MiB, WS_WOUT = 28 * MiB, WS_WGU = 36 * MiB, WS_WDN = 80 * MiB;
constexpr size_t WS_XN = 104 * MiB, WS_MIX = 168 * MiB;
constexpr size_t WS_QD = 232 * MiB, WS_KD = 264 * MiB, WS_VD = 296 * MiB, WS_CQ = 328 * MiB, WS_CKV = 344 * MiB, WS_QM = 352 * MiB, WS_KM = 400 * MiB, WS_VM = 448 * MiB;
constexpr size_t WS_H = 232 * MiB;
constexpr size_t WS_X1B = 408 * MiB;
constexpr size_t WS_END = 480 * MiB;
constexpr int CW_BAR = 4096;
constexpr int RING_OFF = 0, RING_BYTES = 131072, EPI_OFF = 131072, LDSCTL_OFF = 139264, MISC_OFF = LDSCTL_OFF + 320, LDS_BYTES = 147456;

typedef GAS unsigned gu32;
#define RLX_AGENT __ATOMIC_RELAXED, __HIP_MEMORY_SCOPE_AGENT
#define LDS_WAIT() asm volatile("s_waitcnt lgkmcnt(0)" ::: "memory")

#define XB_TMO      128
#define XB_XCNT(j)  (256  + 64 * (j))
#define XB_XSUB(j)  (1280 + 64 * (j))
#define XB_XGEN(j)  (2304 + 64 * (j))
#define XB_TOP      3328
#define XB_TOPGEN   3392
#define XCD_BAR_WORDS 3456
#define XB_SPIN_CAP (1u << 18)
__device__ __forceinline__ unsigned xb_ld(unsigned* p)              { return __hip_atomic_load(p, __ATOMIC_RELAXED, __HIP_MEMORY_SCOPE_AGENT); }
__device__ __forceinline__ unsigned xb_add(unsigned* p, unsigned v) { return __hip_atomic_fetch_add(p, v, __ATOMIC_RELAXED, __HIP_MEMORY_SCOPE_AGENT); }
__device__ __forceinline__ unsigned xb_xcc_id() { return (unsigned)__builtin_amdgcn_s_getreg((3 << 11) | 20) & 0xFu; }
#define XB_SPIN(cond, bar) do { unsigned _sp = 0; while (cond) { __builtin_amdgcn_s_sleep(1); \
    if ((++_sp & 255u) == 0u) { if (xb_ld(&(bar)[XB_TMO])) break; if (_sp > XB_SPIN_CAP) { atomicAdd(&(bar)[XB_TMO], 1u); break; } } } } while (0)
struct XcdBarrier { unsigned* bar; unsigned x; volatile LAS unsigned* st; };
__device__ __forceinline__ XcdBarrier xcd_barrier_post(unsigned* bar, volatile LAS unsigned* st) {
    XcdBarrier b; b.bar = bar; b.x = xb_xcc_id(); b.st = st;
    if (threadIdx.x == 0) (void)xb_add(&bar[XB_XCNT(b.x)], 1u);
    return b;
}
__device__ __forceinline__ void xcd_barrier_complete(unsigned* bar, unsigned x, unsigned& nloc, unsigned& nx) {
    const unsigned G = gridDim.x * gridDim.y * gridDim.z;
    unsigned sum, cnt, mine, sp = 0u;
    for (;;) {
        sum = 0u; cnt = 0u; mine = 0u;
#pragma unroll
        for (unsigned j = 0; j < 16; ++j) { const unsigned c = xb_ld(&bar[XB_XCNT(j)]); sum += c; cnt += (c > 0u) ? 1u : 0u; mine = (j == x) ? c : mine; }
        if (sum == G) break;
        __builtin_amdgcn_s_sleep(1);
        if ((++sp & 255u) == 0u) { if (xb_ld(&bar[XB_TMO])) break; if (sp > XB_SPIN_CAP) { atomicAdd(&bar[XB_TMO], 1u); break; } }
    }
    nloc = mine > 0u ? mine : 1u; nx = cnt > 0u ? cnt : 1u;
}
__device__ __forceinline__ void xcd_barrier(const XcdBarrier& b) {
    asm volatile("s_waitcnt vmcnt(0)" ::: "memory");
    __syncthreads();
    if (threadIdx.x == 0) {
        unsigned* bar = b.bar;
        __builtin_amdgcn_s_waitcnt(0);
        unsigned nloc = b.st[0], nx = b.st[1];
        if (nloc == 0u) { xcd_barrier_complete(bar, b.x, nloc, nx); b.st[0] = nloc; b.st[1] = nx; }
        const unsigned old = xb_add(&bar[XB_XSUB(b.x)], 1u);
        const unsigned gen = old / nloc;
        if (old + 1u == (gen + 1u) * nloc) {
            __builtin_amdgcn_fence(__ATOMIC_RELEASE, "agent");
            asm volatile("s_waitcnt vmcnt(0)" ::: "memory");
            const unsigned og = xb_add(&bar[XB_TOP], 1u);
            const unsigned tg = og / nx;
            if (og + 1u == (tg + 1u) * nx) xb_add(&bar[XB_TOPGEN], 1u);
            else XB_SPIN(xb_ld(&bar[XB_TOPGEN]) == tg, bar);
            __builtin_amdgcn_fence(__ATOMIC_ACQUIRE, "agent");
            xb_add(&bar[XB_XGEN(b.x)], 1u);
            asm volatile("s_waitcnt vmcnt(0)" ::: "memory");
        } else {
            XB_SPIN(xb_ld(&bar[XB_XGEN(b.x)]) == gen, bar);
            __builtin_amdgcn_fence(__ATOMIC_ACQUIRE, "agent");
            asm volatile("s_waitcnt vmcnt(0)" ::: "memory");
        }
    }
    __syncthreads();
}

__device__ __forceinline__ float wave_sum(float v) {
#pragma unroll
    for (int o = 1; o < 64; o <<= 1) v += __shfl_xor(v, o);
    return v;
}

enum RowMap { RM_ID = 0, RM_G64 = 1, RM_QB = 2, RM_GATE = 3, RM_UP = 4, RM_P32 = 5 };
__device__ __forceinline__ int rowmap(int kind, int n) {
    switch (kind) {
        case RM_G64:  return (n & ~255) + pmap256(n & 255);
        case RM_QB:   { const int hh = n / 192, d = n - hh * 192; return hh * 256 + pmap256(d); }
        case RM_GATE: return (n >> 7) * 256 + pmap128(n & 127);
        case RM_UP:   return (n >> 7) * 256 + 128 + pmap128(n & 127);
        case RM_P32:  return (n & ~31) + 16 * ((n >> 2) & 1) + 4 * ((n >> 3) & 3) + (n & 3);
        default:      return n;
    }
}
__device__ __forceinline__ void p0_transpose_item(const float* W, int K, int N, bf16_t* WT, int kind, const float* kscale, LAS float* scr, int item, int lane) {
    const int nblk = N / 32, kb = item / nblk, nb = item % nblk, k0 = 64 * kb, n0 = 32 * nb;
    f32x4 t[8];
#pragma unroll
    for (int i = 0; i < 8; ++i) t[i] = __builtin_nontemporal_load((const f32x4*)(W + (size_t)(k0 + 8 * i + (lane >> 3)) * N + n0 + 4 * (lane & 7)));
    LAS char* tl = (LAS char*)scr;
#pragma unroll
    for (int i = 0; i < 8; ++i) { const int kk = 8 * i + (lane >> 3); f32x4 v = t[i]; if (kscale) v = v * kscale[k0 + kk];
        u32x2 w; w.x = cvt_pk_bf16(v[0], v[1]); w.y = cvt_pk_bf16(v[2], v[3]); *(LAS u32x2*)(tl + kk * 64 + 8 * (lane & 7)) = w; }
    LDS_WAIT(); asm volatile("" ::: "memory");
    const int g = lane >> 4, i16 = lane & 15, q = i16 >> 2, p = i16 & 3;
    const int ra = (int)(uintptr_t)tl + (8 * (g >> 1) + q) * 64 + 32 * (g & 1) + 8 * p;
    bf16_t* dst = WT + (size_t)rowmap(kind, n0 + 16 * (g & 1) + i16) * K + k0 + 8 * (g >> 1);
    s16x4 lo[4], hi[4];
#pragma unroll
    for (int j = 0; j < 4; ++j) { asm volatile("ds_read_b64_tr_b16 %0, %1 offset:%2" : "=&v"(lo[j]) : "v"(ra), "i"(j * 1024) : "memory");
                                  asm volatile("ds_read_b64_tr_b16 %0, %1 offset:%2" : "=&v"(hi[j]) : "v"(ra), "i"(j * 1024 + 256) : "memory"); }
    asm volatile("s_waitcnt lgkmcnt(0)" : "+v"(lo[0]), "+v"(lo[1]), "+v"(lo[2]), "+v"(lo[3]), "+v"(hi[0]), "+v"(hi[1]), "+v"(hi[2]), "+v"(hi[3]) :: "memory");
#pragma unroll
    for (int j = 0; j < 4; ++j) { const bf16x8 o = {lo[j][0], lo[j][1], lo[j][2], lo[j][3], hi[j][0], hi[j][1], hi[j][2], hi[j][3]}; *(bf16x8*)(dst + 16 * j) = o; }
    asm volatile("" ::: "memory");
}
__device__ __forceinline__ void p0_ada_item(const float* cvec, const float* w_ada, const float* b_ada, float* MOD, LAS float* cs, int item, int lane) {
    const int cg = item % 192, kc = item / 192, c0 = cg * 64, k0 = kc * 64;
    { f32x4 a;
#pragma unroll
      for (int b = 0; b < 4; ++b) { const float v = cvec[b * DM + k0 + lane]; a[b] = v * __builtin_amdgcn_rcpf(1.f + ex2(-v * LOG2E)); }
      *(LAS f32x4*)(cs + lane * 4) = a; }
    LDS_WAIT(); asm volatile("" ::: "memory");
    f32x4 acc[4] = {};
    const float* wp = w_ada + (size_t)(k0 + (lane >> 4)) * MODW + c0 + 4 * (lane & 15);
    f32x4 w[16];
#pragma unroll
    for (int i = 0; i < 16; ++i) w[i] = __builtin_nontemporal_load((const f32x4*)(wp + (size_t)(4 * i) * MODW));
#pragma unroll
    for (int i = 0; i < 16; ++i) { const f32x4 cb = *(const LAS f32x4*)(cs + (4 * i + (lane >> 4)) * 4);
#pragma unroll
        for (int b = 0; b < 4; ++b) acc[b] += w[i] * cb[b]; }
#pragma unroll
    for (int b = 0; b < 4; ++b)
#pragma unroll
        for (int e = 0; e < 4; ++e) { float v = acc[b][e]; v += __shfl_xor(v, 16); v += __shfl_xor(v, 32); acc[b][e] = v; }
    if (lane < 16) {
        const int col = c0 + 4 * lane;
#pragma unroll
        for (int b = 0; b < 4; ++b)
#pragma unroll
            for (int e = 0; e < 4; ++e) { float v = acc[b][e]; if (kc == 0) v += b_ada[col + e]; atomicAdd(MOD + b * MODW + col + e, v); }
    }
    LDS_WAIT(); asm volatile("" ::: "memory");
}
template <typename TIN>
__device__ __forceinline__ void modnorm_rows8(const TIN* xrows, const float* g, const float* sh, const float* sc, bf16_t* orows, int lane) {
    f32x4 gs[4][2], hs[4][2];
#pragma unroll
    for (int j = 0; j < 4; ++j)
#pragma unroll
        for (int h2 = 0; h2 < 2; ++h2) { const int col = 8 * (lane + 64 * j) + 4 * h2; gs[j][h2] = *(const f32x4*)(g + col) * (*(const f32x4*)(sc + col) + 1.f); hs[j][h2] = *(const f32x4*)(sh + col); }
#pragma unroll 2
    for (int r = 0; r < 8; ++r) {
        f32x4 v[4][2]; float s = 0.f;
        if constexpr (sizeof(TIN) == 4) {
#pragma unroll
            for (int j = 0; j < 4; ++j)
#pragma unroll
                for (int h2 = 0; h2 < 2; ++h2) v[j][h2] = *(const f32x4*)((const float*)xrows + (size_t)r * DM + 8 * (lane + 64 * j) + 4 * h2);
        } else {
            bf16x8 q[4];
#pragma unroll
            for (int j = 0; j < 4; ++j) q[j] = *(const bf16x8*)((const bf16_t*)xrows + (size_t)r * DM + 8 * (lane + 64 * j));
#pragma unroll
            for (int j = 0; j < 4; ++j)
#pragma unroll
                for (int h2 = 0; h2 < 2; ++h2)
#pragma unroll
                    for (int e = 0; e < 4; ++e) v[j][h2][e] = bf2f((unsigned short)q[j][4 * h2 + e]);
        }
#pragma unroll
        for (int j = 0; j < 4; ++j)
#pragma unroll
            for (int h2 = 0; h2 < 2; ++h2) { const f32x4 x = v[j][h2]; s += (x[0] * x[0] + x[1] * x[1]) + (x[2] * x[2] + x[3] * x[3]); }
        const float rs = rsq(wave_sum(s) * (1.f / DM) + EPS);
#pragma unroll
        for (int j = 0; j < 4; ++j) { const f32x4 y0 = v[j][0] * rs * gs[j][0] + hs[j][0], y1 = v[j][1] * rs * gs[j][1] + hs[j][1];
            u32x4 w; w.x = cvt_pk_bf16(y0[0], y0[1]); w.y = cvt_pk_bf16(y0[2], y0[3]); w.z = cvt_pk_bf16(y1[0], y1[1]); w.w = cvt_pk_bf16(y1[2], y1[3]);
            *(u32x4*)(orows + (size_t)r * DM + 8 * (lane + 64 * j)) = w; }
    }
}

struct Args { const float* in[22]; float* out; unsigned char* ws; int ph_lo, ph_hi; };

__global__ void __launch_bounds__(NWAVES * 64, 2) mk_fwd(Args args) {
    extern __shared__ __attribute__((aligned(16))) unsigned char lds_raw[];
    LAS unsigned char* lds = (LAS unsigned char*)lds_raw;
    volatile LAS unsigned* MISC = (volatile LAS unsigned*)(lds + MISC_OFF);
    const int tid = threadIdx.x, lane = tid & 63, wave = __builtin_amdgcn_readfirstlane(tid >> 6);
    const int G = gridDim.x; const int bx = blockIdx.x; const int vcu = (G % 8 == 0) ? (bx % 8) * (G / 8) + bx / 8 : bx;
    unsigned char* ws = args.ws;
    gu32* ctl = (gu32*)(ws + WS_CTL);
    const float* x = args.in[0]; const float* cvec = args.in[1]; const float* relb = args.in[2]; const float* w_ada = args.in[3]; const float* b_ada = args.in[4];
    const float* g_norm1 = args.in[5]; const float* w_in = args.in[6]; const float* g_q_diff = args.in[7]; const float* g_k_diff = args.in[8]; const float* lambda_vecs = args.in[9];
    const float* g_subln = args.in[10]; const float* g_q_a = args.in[11]; const float* w_q_b = args.in[12]; const float* g_kv_a = args.in[13]; const float* w_kv_b = args.in[14];
    const float* g_q_mla = args.in[15]; const float* g_k_mla = args.in[16]; const float* w_out = args.in[17]; const float* g_norm2 = args.in[18];
    const float* w_gate = args.in[19]; const float* w_up = args.in[20]; const float* w_down = args.in[21];
    float* out = args.out;
    float* MOD = (float*)(ws + WS_MOD); float* ROPEC = (float*)(ws + WS_ROPEC); float* ROPES = (float*)(ws + WS_ROPES);
    float* SSQ_Q = (float*)(ws + WS_SSQ_Q); float* SSQ_KV = (float*)(ws + WS_SSQ_KV); float* SSQ_PE = (float*)(ws + WS_SSQ_PE); float* KR = (float*)(ws + WS_KR);
    bf16_t* WIN_T = (bf16_t*)(ws + WS_WIN); bf16_t* WQB_T = (bf16_t*)(ws + WS_WQB); bf16_t* WKVB_T = (bf16_t*)(ws + WS_WKVB); bf16_t* WOUT_T = (bf16_t*)(ws + WS_WOUT);
    bf16_t* WGU_T = (bf16_t*)(ws + WS_WGU); bf16_t* WDN_T = (bf16_t*)(ws + WS_WDN);
    bf16_t* XN = (bf16_t*)(ws + WS_XN); bf16_t* MIX = (bf16_t*)(ws + WS_MIX);
    bf16_t* QD = (bf16_t*)(ws + WS_QD); bf16_t* KD = (bf16_t*)(ws + WS_KD); bf16_t* VD = (bf16_t*)(ws + WS_VD); bf16_t* CQ = (bf16_t*)(ws + WS_CQ); bf16_t* CKV = (bf16_t*)(ws + WS_CKV);
    bf16_t* QM = (bf16_t*)(ws + WS_QM); bf16_t* KM = (bf16_t*)(ws + WS_KM); bf16_t* VM = (bf16_t*)(ws + WS_VM); bf16_t* HB = (bf16_t*)(ws + WS_H); bf16_t* X1B = (bf16_t*)(ws + WS_X1B);

    for (int u = tid; u < (LDS_BYTES - LDSCTL_OFF) / 4; u += NWAVES * 64) ((LAS unsigned*)(lds + LDSCTL_OFF))[u] = 0u;
    __syncthreads();
    XcdBarrier bar; bar.bar = (unsigned*)(ctl + CW_BAR); bar.x = 0; bar.st = nullptr;
    if (MK_LAUNCHES == 1) bar = xcd_barrier_post((unsigned*)(ctl + CW_BAR), MISC + 8);
    const int lo = args.ph_lo, hi = args.ph_hi;
#ifndef PHMASK
#define PHMASK 0x1ff
#endif
#define IN(k) (((PHMASK >> (k)) & 1) && lo <= (k) && (k) < hi)
#define SEAM(k) do { if (IN(k) && IN((k) + 1)) xcd_barrier(bar); } while (0)
    LAS float* EPIP = (LAS float*)(lds + EPI_OFF);

    if (IN(0)) {
        LAS float* scr = (LAS float*)(lds + RING_OFF + wave * 16384);
        const int gw = wave * G + vcu, NGW = G * NWAVES;
        constexpr int I_ADA = 192 * 32, I_IN = (DM / 64) * (INC / 32), I_QB = (512 / 64) * (1536 / 32), I_KVB = (256 / 64) * (2048 / 32), I_OUT = (DM / 64) * (DM / 32),
                      I_G = (DM / 64) * (DFF / 32), I_DN = (DFF / 64) * (DM / 32), I_ZERO = 192 + 512, I_ROPE = SEQ * 32 / 64;
        constexpr int NITEMS = I_ADA + I_IN + I_QB + I_KVB + I_OUT + 2 * I_G + I_DN + I_ZERO + I_ROPE;
        for (int it = gw; it < NITEMS; it += NGW) {
            int r = it;
            if (r < I_ADA) { p0_ada_item(cvec, w_ada, b_ada, MOD, scr, r, lane); continue; } r -= I_ADA;
            if (r < I_IN) { p0_transpose_item(w_in, DM, INC, WIN_T, RM_G64, nullptr, scr, r, lane); continue; } r -= I_IN;
            if (r < I_QB) { p0_transpose_item(w_q_b, 512, 1536, WQB_T, RM_QB, g_q_a, scr, r, lane); continue; } r -= I_QB;
            if (r < I_KVB) { p0_transpose_item(w_kv_b, 256, 2048, WKVB_T, RM_G64, g_kv_a, scr, r, lane); continue; } r -= I_KVB;
            if (r < I_OUT) { p0_transpose_item(w_out, DM, DM, WOUT_T, RM_P32, nullptr, scr, r, lane); continue; } r -= I_OUT;
            if (r < I_G) { p0_transpose_item(w_gate, DM, DFF, WGU_T, RM_GATE, nullptr, scr, r, lane); continue; } r -= I_G;
            if (r < I_G) { p0_transpose_item(w_up, DM, DFF, WGU_T, RM_UP, nullptr, scr, r, lane); continue; } r -= I_G;
            if (r < I_DN) { p0_transpose_item(w_down, DFF, DM, WDN_T, RM_P32, nullptr, scr, r, lane); continue; } r -= I_DN;
            if (r < I_ZERO) {
                if (r < 192) { bf16_t* p = WIN_T + (size_t)rowmap(RM_G64, INC + r) * DM;
#pragma unroll
                    for (int j = 0; j < 4; ++j) *(u32x4*)(p + (lane + 64 * j) * 8) = (u32x4){0u, 0u, 0u, 0u}; }
                else { const int q = r - 192, hh = q >> 6, d = 192 + (q & 63); bf16_t* p = WQB_T + (size_t)(hh * 256 + pmap256(d)) * 512; *(u32x4*)(p + lane * 8) = (u32x4){0u, 0u, 0u, 0u}; }
                continue; } r -= I_ZERO;
            {
                const int e = 64 * r + lane, pos = e >> 5, i = e & 31;
                double inv = 1.0; for (int t = 0; t < i; ++t) inv *= 0.7498942093324559;
                double rev = (double)pos * inv * 0.15915494309189535; rev -= (double)(long long)rev;
                ROPEC[e] = __builtin_amdgcn_cosf((float)rev); ROPES[e] = __builtin_amdgcn_sinf((float)rev);
            }
        }
        SEAM(0);
    }
    if (IN(1)) {
        const int gw = vcu * NWAVES + wave, NGW = G * NWAVES;
        for (int m = 8 * gw; m < M; m += 8 * NGW) { const int b = m >> 12; modnorm_rows8<float>(x + (size_t)m * DM, g_norm1, MOD + b * MODW, MOD + b * MODW + DM, XN + (size_t)m * DM, lane); }
        SEAM(1);
    }
    if (IN(2)) {
        pg8::Gemm g{XN, WIN_T, M, INP, DM}; pg8::StaticOrder S; S.init(M, INP, G, bx);
        EpiProj E{QD, KD, VD, CQ, CKV, SSQ_Q, SSQ_KV, SSQ_PE, KR, g_q_diff, g_k_diff, g_k_mla, ROPEC, ROPES};
        pg8::gemm_phase(lds + RING_OFF, g, S, E);
        SEAM(2);
    }
    if (IN(3)) {
        { pg8::Gemm g{CQ, WQB_T, M, 2048, 512}; pg8::StaticOrder S; S.init(M, 2048, G, bx);
          EpiQ E{QM, SSQ_Q, g_q_mla, ROPEC, ROPES, EPIP};
          pg8::gemm_phase(lds + RING_OFF, g, S, E); }
        { pg8::Gemm g{CKV, WKVB_T, M, 2048, 256}; pg8::StaticOrder S; S.init(M, 2048, G, bx);
          EpiKV E{ws + WS_XN, ws + WS_XN + 40 * MiB, SSQ_KV, SSQ_PE, KR, g_k_mla, EPIP};
          pg8::gemm_phase(lds + RING_OFF, g, S, E); }
        SEAM(3);
    }
    if (IN(4)) {
        float d01 = 0.f, d23 = 0.f;
        for (int i = 0; i < 64; ++i) { d01 += lambda_vecs[i] * lambda_vecs[64 + i]; d23 += lambda_vecs[128 + i] * lambda_vecs[192 + i]; }
        const float lam = __expf(d01) - __expf(d23) + 0.2f;
#ifndef ATT_MASK
#define ATT_MASK 3
#endif
        unsigned char* K8 = ws + WS_XN; unsigned char* VT8 = ws + WS_XN + 40 * MiB;
        unsigned char* KD8 = (unsigned char*)KD; unsigned char* VTD8 = (unsigned char*)VD;
        if (ATT_MASK & 1) { att::TensorsD8 T{QD, KD8, VTD8, MIX};
          for (int uu = vcu; uu < BATCH * 8 * 32; uu += G) { const int bh = uu >> 5, qb = uu & 31, hh = bh & 7;
              att::attn_unit_diff8(T, bh >> 3, hh, qb, (LAS char*)(lds + RING_OFF), lam, relb, g_subln); } }
        if (ATT_MASK & 2) { att::Tensors8 T{QM, K8, VT8, MIX, ROPEC, ROPES};
          for (int uu = vcu; uu < BATCH * 8 * 16; uu += G) { const int bh = uu >> 4, qb = uu & 15;
              att::attn_unit_mla8(T, bh >> 3, bh & 7, qb, (LAS char*)(lds + RING_OFF)); } }
        SEAM(4);
    }
    if (IN(5)) {
        pg8::Gemm g{MIX, WOUT_T, M, DM, DM}; pg8::StaticOrder S; S.init(M, DM, G, bx);
        EpiRes1 E{x, MOD + 2 * DM, X1B};
        pg8::gemm_phase(lds + RING_OFF, g, S, E);
        SEAM(5);
    }
    if (IN(6)) {
        const int gw = vcu * NWAVES + wave, NGW = G * NWAVES;
        for (int m = 8 * gw; m < M; m += 8 * NGW) { const int b = m >> 12; modnorm_rows8<bf16_t>(X1B + (size_t)m * DM, g_norm2, MOD + b * MODW + 3 * DM, MOD + b * MODW + 4 * DM, XN + (size_t)m * DM, lane); }
        SEAM(6);
    }
    if (IN(7)) {
        pg8::Gemm g{XN, WGU_T, M, 2 * DFF, DM}; pg8::StaticOrder S; S.init(M, 2 * DFF, G, bx);
        EpiSwiglu E{HB};
        pg8::gemm_phase(lds + RING_OFF, g, S, E);
        SEAM(7);
    }
    if (IN(8)) {
        pg8::Gemm g{HB, WDN_T, M, DM, DFF}; pg8::StaticOrder S; S.init(M, DM, G, bx);
        EpiRes2 E{X1B, MOD + 5 * DM, out};
        pg8::gemm_phase(lds + RING_OFF, g, S, E);
    }
#undef IN
#undef SEAM
}

extern "C" void kernel_launch(void* const* d_in, const int* in_sizes, int n_in, void* d_out, int out_size, void* d_ws, size_t ws_size, hipStream_t stream) {
    static int grid = 0;
    if (grid == 0) {
        if (n_in != 22 || in_sizes[0] != M * DM || out_size != M * DM || ws_size < WS_END) { fprintf(stderr, "kernel_launch: unexpected shapes (n_in %d, in0 %d, out %d, ws %zu)\n", n_in, n_in > 0 ? in_sizes[0] : -1, out_size, ws_size); grid = -1; return; }
        int dev = 0, cus = 0, per_cu = 0;
        if (hipGetDevice(&dev) != hipSuccess || hipDeviceGetAttribute(&cus, hipDeviceAttributeMultiprocessorCount, dev) != hipSuccess) { grid = -1; return; }
        if (hipFuncSetAttribute((const void*)mk_fwd, hipFuncAttributeMaxDynamicSharedMemorySize, LDS_BYTES) != hipSuccess) { fprintf(stderr, "kernel_launch: hipFuncSetAttribute failed\n"); grid = -1; return; }
        if (hipOccupancyMaxActiveBlocksPerMultiprocessor(&per_cu, (const void*)mk_fwd, NWAVES * 64, LDS_BYTES) != hipSuccess || per_cu < 1) { fprintf(stderr, "kernel_launch: occupancy query says %d\n", per_cu); per_cu = 1; }
        (void)hipGetLastError();
        grid = cus;
    }
    if (grid < 0) return;
    (void)hipMemsetAsync((char*)d_ws + WS_CTL, 0, CTL_ZERO_BYTES, stream);
    Args a{};
    for (int i = 0; i < 22; ++i) a.in[i] = (const float*)d_in[i];
    a.out = (float*)d_out; a.ws = (unsigned char*)d_ws;
    for (int li = 0; li < MK_LAUNCHES; ++li) {
        a.ph_lo = (MK_LAUNCHES == 1) ? 0 : li; a.ph_hi = (MK_LAUNCHES == 1) ? NPH : li + 1;
        hipLaunchKernelGGL(mk_fwd, dim3(grid), dim3(NWAVES * 64), LDS_BYTES, stream, a);
    }
    const hipError_t le = hipPeekAtLastError();
    if (le != hipSuccess) fprintf(stderr, "kernel_launch: launch failed: %s\n", hipGetErrorName(le));
}
```
